# Optimizing an MI355X kernel written in HIP

```python
import math
import jax, jax.numpy as jnp
from jax import lax
import numpy as np

D_MODEL = 1024
BATCH = 4
SEQ = 4096
DEPTH = 1

N_META = 16
MIX_WIDTH = D_MODEL
ATTN_WIDTH = MIX_WIDTH // 2
POOL_WIDTH = MIX_WIDTH - ATTN_WIDTH
ATTN_HEADS = 4
ATTN_VDIM = ATTN_WIDTH // ATTN_HEADS
ATTN_QKDIM = ATTN_VDIM // 2
POOL_WINDOWS = (2, 4, 8, 16)
POOL_GROUPS = len(POOL_WINDOWS)
POOL_GDIM = POOL_WIDTH // POOL_GROUPS
N_EXPERTS = 16
EC_CAPACITY_FACTOR = 2
D_FF_EXPERT = 2816
Q_BLOCK = 128
EPS = 1e-6
IN_WIDTH = 4 * ATTN_HEADS * ATTN_QKDIM + ATTN_WIDTH + POOL_WIDTH

kernel_name = "hybrid_diffattn_pool_ecmoe_encoder"


def rmsnorm(x, g):
    xf = x.astype(jnp.float32)
    y = xf * lax.rsqrt(jnp.mean(xf * xf, axis=-1, keepdims=True) + EPS)
    return (y * g.astype(jnp.float32)).astype(x.dtype)


def alibi_slopes(n_heads):
    return jnp.array([2.0 ** (-8.0 * (i + 1) / n_heads) for i in range(n_heads)], dtype=jnp.float32)


def diff_attention(q1, q2, k1, k2, v, lam):
    B, L, H, d = q1.shape
    scale = 1.0 / math.sqrt(d)
    slopes = alibi_slopes(H)
    n_blk = -(-L // Q_BLOCK)
    Lp = n_blk * Q_BLOCK
    tr = lambda t: jnp.transpose(t, (0, 2, 1, 3))
    q1, q2, k1, k2, v = tr(q1), tr(q2), tr(k1), tr(k2), tr(v)
    pad = ((0, 0), (0, 0), (0, Lp - L), (0, 0))
    to_blocks = lambda q: jnp.moveaxis(jnp.pad(q, pad).reshape(B, H, n_blk, Q_BLOCK, d), 2, 0)
    q1b, q2b = to_blocks(q1), to_blocks(q2)
    starts = jnp.arange(n_blk, dtype=jnp.int32) * Q_BLOCK
    kpos = jnp.arange(L, dtype=jnp.float32)

    def block(args):
        qa, qb, start = args
        qpos = (start + jnp.arange(Q_BLOCK, dtype=jnp.int32)).astype(jnp.float32)
        dist = jnp.abs(qpos[:, None] - kpos[None, :])
        bias = -slopes[:, None, None] * dist[None]
        s1 = jnp.einsum('bhqd,bhkd->bhqk', qa, k1).astype(jnp.float32) * scale + bias
        s2 = jnp.einsum('bhqd,bhkd->bhqk', qb, k2).astype(jnp.float32) * scale + bias
        att = jax.nn.softmax(s1, axis=-1) - lam * jax.nn.softmax(s2, axis=-1)
        return jnp.einsum('bhqk,bhkv->bhqv', att.astype(v.dtype), v)

    out = lax.map(block, (q1b, q2b, starts))
    out = jnp.moveaxis(out, 0, 2).reshape(B, H, Lp, v.shape[-1])[:, :, :L]
    return jnp.transpose(out, (0, 2, 1, 3))


def multiscale_pool(u, pool_w, pool_scale):
    B, L, _ = u.shape
    uf = u.astype(jnp.float32)
    cs = jnp.concatenate([jnp.zeros((B, 1, POOL_WIDTH), jnp.float32), jnp.cumsum(uf, axis=1)], axis=1)
    t = jnp.arange(L, dtype=jnp.int32)
    parts = []
    for gi, w in enumerate(POOL_WINDOWS):
        sl = slice(gi * POOL_GDIM, (gi + 1) * POOL_GDIM)
        lo = jnp.clip(t - w // 2, 0, L)
        hi = jnp.clip(t + w // 2, 0, L)
        csg = cs[:, :, sl]
        cnt = (hi - lo).astype(jnp.float32)[None, :, None]
        parts.append((csg[:, hi] - csg[:, lo]) / cnt)
    pooled = (jnp.concatenate(parts, axis=-1) - uf).astype(u.dtype)
    pg = pooled.reshape(B, L, POOL_GROUPS, POOL_GDIM)
    y = jnp.einsum('blgc,gcd->blgd', pg, pool_w).reshape(B, L, POOL_WIDTH)
    return y * pool_scale


def expert_choice_moe(h, router_w, w_gate, w_up, w_down):
    B, L, D = h.shape
    C = EC_CAPACITY_FACTOR * L // N_EXPERTS
    logits = jnp.einsum('bld,de->ble', h, router_w).astype(jnp.float32)
    aff = jax.nn.softmax(logits, axis=-1)
    gate, idx = lax.top_k(jnp.swapaxes(aff, 1, 2), C)
    xg = jax.vmap(lambda hb, ib: hb[ib])(h, idx)
    hid = jax.nn.silu(jnp.einsum('becd,edf->becf', xg, w_gate)) * jnp.einsum('becd,edf->becf', xg, w_up)
    y = jnp.einsum('becf,efd->becd', hid, w_down) * gate[..., None].astype(h.dtype)
    return jax.vmap(lambda yb, ib: jnp.zeros((L, D), yb.dtype).at[ib.reshape(-1)].add(yb.reshape(-1, D)))(y, idx)


def setup_inputs(seed: int = 0) -> dict:
    key = jax.random.key(seed)
    ks = jax.random.split(key, 16)
    f32 = jnp.float32
    nrm = lambda k, s, sc: jax.random.normal(k, s, f32) * sc
    return {
        "x": jax.random.normal(ks[0], (BATCH, SEQ, D_MODEL), f32),
        "meta_tokens": nrm(ks[1], (N_META, D_MODEL), 1.0),
        "g_mix": 1.0 + nrm(ks[2], (DEPTH, D_MODEL), 0.02),
        "w_in": nrm(ks[3], (DEPTH, D_MODEL, IN_WIDTH), D_MODEL ** -0.5),
        "lam_vecs": nrm(ks[4], (DEPTH, 4, ATTN_QKDIM), 0.1),
        "subln_gain": 1.0 + nrm(ks[5], (DEPTH, ATTN_VDIM), 0.02),
        "pool_w": nrm(ks[6], (DEPTH, POOL_GROUPS, POOL_GDIM, POOL_GDIM), POOL_GDIM ** -0.5),
        "pool_scale": 1.0 + nrm(ks[7], (DEPTH, POOL_WIDTH), 0.02),
        "w_o": nrm(ks[8], (DEPTH, MIX_WIDTH, D_MODEL), MIX_WIDTH ** -0.5),
        "g_ffn": 1.0 + nrm(ks[9], (DEPTH, D_MODEL), 0.02),
        "router_w": nrm(ks[10], (DEPTH, D_MODEL, N_EXPERTS), D_MODEL ** -0.5),
        "w_gate": nrm(ks[11], (DEPTH, N_EXPERTS, D_MODEL, D_FF_EXPERT), D_MODEL ** -0.5),
        "w_up": nrm(ks[12], (DEPTH, N_EXPERTS, D_MODEL, D_FF_EXPERT), D_MODEL ** -0.5),
        "w_down": nrm(ks[13], (DEPTH, N_EXPERTS, D_FF_EXPERT, D_MODEL), D_FF_EXPERT ** -0.5),
        "g_final": 1.0 + nrm(ks[14], (D_MODEL,), 0.02),
    }


def reference(x, meta_tokens, g_mix, w_in, lam_vecs, subln_gain, pool_w, pool_scale, w_o,
              g_ffn, router_w, w_gate, w_up, w_down, g_final):
    B = x.shape[0]
    meta = jnp.broadcast_to(meta_tokens[None].astype(x.dtype), (B, N_META, D_MODEL))
    h = jnp.concatenate([meta, x], axis=1)
    L = h.shape[1]
    H, d = ATTN_HEADS, ATTN_QKDIM
    qk = H * d
    for l in range(DEPTH):
        lam_init = 0.8 - 0.6 * math.exp(-0.3 * l)
        n = rmsnorm(h, g_mix[l])
        proj = jnp.einsum('bld,de->ble', n, w_in[l])
        q1 = proj[..., 0 * qk:1 * qk].reshape(B, L, H, d)
        q2 = proj[..., 1 * qk:2 * qk].reshape(B, L, H, d)
        k1 = proj[..., 2 * qk:3 * qk].reshape(B, L, H, d)
        k2 = proj[..., 3 * qk:4 * qk].reshape(B, L, H, d)
        v = proj[..., 4 * qk:4 * qk + ATTN_WIDTH].reshape(B, L, H, ATTN_VDIM)
        u = proj[..., 4 * qk + ATTN_WIDTH:]
        lv = lam_vecs[l].astype(jnp.float32)
        lam = jnp.exp(jnp.sum(lv[0] * lv[1])) - jnp.exp(jnp.sum(lv[2] * lv[3])) + lam_init
        a = diff_attention(q1, q2, k1, k2, v, lam)
        a = (rmsnorm(a, subln_gain[l]) * (1.0 - lam_init)).reshape(B, L, ATTN_WIDTH)
        p = multiscale_pool(u, pool_w[l], pool_scale[l])
        mix = jnp.concatenate([a, p], axis=-1)
        h = h + jnp.einsum('blm,md->bld', mix, w_o[l])
        h = h + expert_choice_moe(rmsnorm(h, g_ffn[l]), router_w[l], w_gate[l], w_up[l], w_down[l])
    return rmsnorm(h, g_final)[:, N_META:]
```

```cpp
#include <hip/hip_runtime.h>
#include <cstdio>
#include <cstdint>

#ifndef ONE_LAUNCH
#define ONE_LAUNCH 1
#endif
#ifndef PROBE_ABL
#define PROBE_ABL 0
#endif
#ifndef PROBE_NOMMA
#define PROBE_NOMMA 0
#endif
#ifndef PROBE_PF
#define PROBE_PF 0
#endif
#ifndef PROBE_PHASE
#define PROBE_PHASE -1
#endif

#define GAS __attribute__((address_space(1)))
#define LAS __attribute__((address_space(3)))
typedef unsigned short bf16;
typedef short bf16x8 __attribute__((ext_vector_type(8)));
typedef short s16x4 __attribute__((ext_vector_type(4)));
typedef float f32x2 __attribute__((ext_vector_type(2)));
typedef float f32x4 __attribute__((ext_vector_type(4)));
typedef float f32x16 __attribute__((ext_vector_type(16)));
typedef unsigned u32x4 __attribute__((ext_vector_type(4)));
typedef unsigned u32x2 __attribute__((ext_vector_type(2)));
typedef int i32x4 __attribute__((ext_vector_type(4)));

constexpr int NB = 4, SEQ = 4096, NMETA = 16, L = SEQ + NMETA, D = 1024, MTOK = NB * L, MPAD = 16640;
constexpr int NE = 16, CAP = 514, CE = NB * CAP  , CEP = 2304  , FF = 2816, INW = 2048;
constexpr int NH = 4, DQK = 64, DV = 128;
constexpr float EPS = 1e-6f;
constexpr float C2 = 0.125f * 1.4426950408889634f;
constexpr float LOG2E = 1.4426950408889634f;
constexpr int COL_Q1 = 0, COL_Q2 = 256, COL_K1 = 512, COL_K2 = 768, COL_V = 1024, COL_U = 1536;

constexpr size_t MiB = 1u << 20;
constexpr size_t WS_CTL = 0, CTL_ZERO_BYTES = 1 * MiB;
constexpr size_t WS_ROWIDX = 1 * MiB;
constexpr size_t WS_GATE = WS_ROWIDX + 256 * 1024;
constexpr size_t WS_WIN = 2 * MiB;
constexpr size_t WS_WO = 6 * MiB;
constexpr size_t WS_PW = 8 * MiB;
constexpr size_t WS_AFF = 10 * MiB;
constexpr size_t WS_INV = 12 * MiB;
constexpr size_t WS_H1 = 16 * MiB;
constexpr size_t WS_N2 = 81 * MiB;
constexpr size_t WS_BT1 = 114 * MiB;
constexpr size_t WS_BT2 = 290 * MiB;
constexpr size_t WS_C = 378 * MiB;
constexpr size_t WS_XN0 = WS_C;
constexpr size_t WS_QKVU = WS_C + 33 * MiB;
constexpr size_t WS_MIX = WS_C + 99 * MiB;
constexpr size_t WS_PART = WS_C;
constexpr size_t WS_XG = WS_C;
constexpr size_t WS_Y = WS_C;
constexpr size_t WS_HID = WS_C + 72 * MiB;
constexpr size_t WS_END = WS_HID + 198 * MiB;
static_assert(WS_MIX + (size_t)MPAD * 1024 * 2 <= WS_END && WS_HID >= WS_XG + (size_t)NE * CEP * 1024 * 2, "ws map");
static_assert(WS_H1 + (size_t)MTOK * 1024 * 4 <= WS_N2 && WS_N2 + (size_t)MTOK * 1024 * 2 <= WS_BT1, "ws map 2");
static_assert(WS_BT1 + (size_t)NE * 5632 * 1024 * 2 <= WS_BT2 && WS_BT2 + (size_t)NE * 1024 * 2816 * 2 <= WS_C, "ws map 3");
static_assert(WS_AFF + (size_t)NB * NE * L * 4 <= WS_INV && WS_INV + (size_t)MTOK * 16 * 4 <= WS_H1, "ws map 4");

__device__ __forceinline__ unsigned f2bf(float f) { unsigned u = __builtin_bit_cast(unsigned, f); return (u + 0x7fffu + ((u >> 16) & 1u)) >> 16; }
__device__ __forceinline__ unsigned pk2(float lo, float hi) { return f2bf(lo) | (f2bf(hi) << 16); }
__device__ __forceinline__ float bf2f(unsigned short b) { return __builtin_bit_cast(float, ((unsigned)b) << 16); }
__device__ __forceinline__ unsigned cvtpk(float lo, float hi) { unsigned r; asm volatile("v_cvt_pk_bf16_f32 %0, %1, %2" : "=v"(r) : "v"(lo), "v"(hi)); return r; }
__device__ __forceinline__ float wave_sum(float v) {
#pragma unroll
    for (int o = 1; o < 64; o <<= 1) v += __shfl_xor(v, o);
    return v;
}
__device__ __forceinline__ float wave_max(float v) {
#pragma unroll
    for (int o = 1; o < 64; o <<= 1) v = fmaxf(v, __shfl_xor(v, o));
    return v;
}
__device__ __forceinline__ const float* h0_row(const float* x, const float* meta, int m) {
    const int b = m / L, t = m - b * L;
    return t < NMETA ? meta + (size_t)t * D : x + ((size_t)b * SEQ + (t - NMETA)) * D;
}

namespace pg8 {
#define PG8_LAS __attribute__((address_space(3)))
typedef unsigned short bf16_t;
typedef short bf16x8 __attribute__((ext_vector_type(8)));
typedef float f32x4 __attribute__((ext_vector_type(4)));
typedef unsigned u32x4 __attribute__((ext_vector_type(4)));
constexpr int BM = 256, BK = 64, HALF = 128, HTB = HALF * BK * 2  , STAGE_BYTES = 8 * HTB, NXCD = 8, WGM = 8;
constexpr int PFB_DUMMY = 147456 - 256;

__host__ __device__ __forceinline__ int lds_byte(int r, int c) { const int st = (r >> 4) * 2 + (c >> 5), rr = r & 15, cc = c & 31, ob = rr * 64 + cc * 2; return st * 1024 + (ob ^ (((ob >> 9) & 1) << 5)); }
__host__ __device__ __forceinline__ void stage_rc(int b, int& R, int& C) { const int st = b / 1024, sb = b % 1024, swz = sb ^ (((sb >> 9) & 1) << 5); R = (st >> 1) * 16 + swz / 64; C = (st & 1) * 32 + (swz % 64) / 2; }
__host__ __device__ __forceinline__ int perm32(int rho) { const int n = rho >> 4, i = rho & 15; return 8 * (i >> 2) + 4 * n + (i & 3); }

struct Unit { int pm, pn; };
struct Gemm { const bf16_t* A; const bf16_t* Bt; int M, N, K; const int* gidx; };

struct StaticOrder {
    int nM, nN, nwg, G, c, mvalid;
    __host__ __device__ void init(int M, int N, int G_, int c_, int mvalid_) { nM = M / BM; nN = N / BM; nwg = nM * nN; G = G_; c = c_; mvalid = mvalid_; }
    __device__ __forceinline__ int vrows(const Unit& u) const { const int r = mvalid - u.pm * BM; return r < BM ? r : BM; }
    __host__ __device__ bool next(int i, Unit& u) const {
        const long Lx = (long)i * G + c; if (Lx >= nwg) return false;
        int wgid = (int)Lx; { const int q = nwg / NXCD, r = nwg % NXCD, xcd = wgid % NXCD, off = wgid / NXCD; wgid = (xcd < r ? xcd * (q + 1) : r * (q + 1) + (xcd - r) * q) + off; }
        const int nig = WGM * nN, gid = wgid / nig, fm = gid * WGM, gsz = (nM - fm) < WGM ? (nM - fm) : WGM;
        u.pm = fm + ((wgid % nig) % gsz); u.pn = (wgid % nig) / gsz; return true;
    }
    __device__ __forceinline__ void a_ready(const Unit&) const {}
    __device__ __forceinline__ void done(const Unit&) const {}
};

__device__ __forceinline__ unsigned cvt_pk_bf16(float lo, float hi) { unsigned r; asm volatile("v_cvt_pk_bf16_f32 %0, %1, %2" : "=v"(r) : "v"(lo), "v"(hi)); return r; }

template <class Epi, class Sched, bool ALIGN_EPI = false, bool SP2 = false, bool GATHER = false, bool THIN = false, bool PFB = false, int PF = 0  >
__device__ __forceinline__ void gemm_phase(PG8_LAS unsigned char* lds, const Gemm g, const Sched& S, const Epi& E) {
    const int tid = threadIdx.x, wid = __builtin_amdgcn_readfirstlane(tid >> 6), lane = tid & 63, wr = wid >> 2, wc = wid & 3, fr = lane & 15, fq = lane >> 4;
    const int K = g.K, nt = K / BK;
    unsigned voffB[2];
    unsigned vAc[2][2], vAn[2][2];
    int gR[2], gC[2];
#pragma unroll
    for (int i = 0; i < 2; ++i) { int R, C; stage_rc(tid * 16 + i * 8192, R, C); const int Rb = Epi::PERM ? ((R & ~31) + perm32(R & 31)) : R;
        gR[i] = R; gC[i] = C; voffB[i] = (unsigned)((C >> 3) * BM + Rb) * 16u;
        vAc[0][i] = (unsigned)(R * K + C) * 2u; vAc[1][i] = (unsigned)((R + HALF) * K + C) * 2u; vAn[0][i] = vAc[0][i]; vAn[1][i] = vAc[1][i]; }
    const size_t kstep = (size_t)(BK * 2);
    const size_t hstep = (size_t)HALF * K * 2;
    const size_t tstep = 2 * hstep;
    const size_t tstepA = GATHER ? 0 : tstep;
    const size_t kstepB = (size_t)8 * BM * 16, hstepB = (size_t)HALF * 16, tstepB = (size_t)K * (BM * 2);
#define PG8_GOFFS(dst, u) do { if constexpr (GATHER) { _Pragma("unroll") for (int _h = 0; _h < 2; ++_h) _Pragma("unroll") for (int _i = 0; _i < 2; ++_i) \
        dst[_h][_i] = (unsigned)(g.gidx[(u).pm * BM + _h * HALF + gR[_i]] * K + gC[_i]) * 2u; } } while (0)
    const unsigned ldsw = (unsigned)wid * 1024u;
    const int aoff = lds_byte(wr * 64 + fr, fq * 8), boff = lds_byte(wc * 32 + fr, fq * 8);
#define PG8_SA(b, h) (((b) * 2 + (h)) * HTB)
#define PG8_SB(b, h) ((4 + (b) * 2 + (h)) * HTB)
#define PG8_STAGE(bufoff, gbase, voff) do { if constexpr (!(PF & 8)) if (!((PF & 16) && (bufoff) < 4 * HTB) && !((PF & 32) && (bufoff) >= 4 * HTB)) _Pragma("unroll") for (int _i = 0; _i < 2; ++_i) \
        __builtin_amdgcn_global_load_lds((const unsigned*)((const char*)(gbase) + (voff)[_i]), (PG8_LAS unsigned*)(lds + (bufoff) + ldsw + _i * 8192), 16, 0, 0); } while (0)
#define PG8_LDA(dst, b, h) do { if constexpr (!(PF & 4)) _Pragma("unroll") for (int m = 0; m < 4; ++m) _Pragma("unroll") for (int k = 0; k < 2; ++k) dst[m][k] = *(const PG8_LAS bf16x8*)(lds + PG8_SA(b, h) + aoff + m * 2048 + k * 1024); } while (0)
#define PG8_LDB(dst, b, h) do { if constexpr (!(PF & 4)) _Pragma("unroll") for (int n = 0; n < 2; ++n) _Pragma("unroll") for (int k = 0; k < 2; ++k) dst[n][k] = *(const PG8_LAS bf16x8*)(lds + PG8_SB(b, h) + boff + n * 2048 + k * 1024); } while (0)
#define PG8_MMA(ai, bj, At, Bt) do { if (!(PF & 1) && (ai) * HALF + wr * 64 < vr) { __builtin_amdgcn_s_setprio(1); _Pragma("unroll") for (int m = 0; m < 4; ++m) _Pragma("unroll") for (int n = 0; n < 2; ++n) _Pragma("unroll") for (int k = 0; k < 2; ++k) \
        acc[ai][bj][m][n] = __builtin_amdgcn_mfma_f32_16x16x32_bf16(Bt[n][k], At[m][k], acc[ai][bj][m][n], 0, 0, 0); __builtin_amdgcn_s_setprio(0); } } while (0)
#define PG8_WAIT_V(n) asm volatile("s_waitcnt vmcnt(" #n ")" ::: "memory")
#define PG8_WAIT_L(n) asm volatile("s_waitcnt lgkmcnt(" #n ")" ::: "memory")
#define PG8_BAR __builtin_amdgcn_s_barrier()
#define PG8_SCHED __builtin_amdgcn_sched_barrier(0)
    Unit cur, nxt; int ui = 0;
    if (!S.next(0, cur)) return;
    f32x4 acc[2][2][4][2];
#pragma unroll
    for (int a = 0; a < 2; ++a)
#pragma unroll
        for (int b = 0; b < 2; ++b)
#pragma unroll
            for (int m = 0; m < 4; ++m)
#pragma unroll
                for (int n = 0; n < 2; ++n) acc[a][b][m][n] = (f32x4){0.f, 0.f, 0.f, 0.f};
    bf16x8 At[4][2] = {}, B0[2][2] = {}, B1[2][2] = {};
    f32x4 tacc[2] = {(f32x4){0.f, 0.f, 0.f, 0.f}, (f32x4){0.f, 0.f, 0.f, 0.f}}; const char* tp = nullptr; const char* tpn = nullptr; bool thin = false, thinn = false;
    constexpr int TS_OFF = STAGE_BYTES;
    const int troff = (fr & 7) * 128 + fq * 16;
#define PG8_TPTR(dstp, dstf, u) do { if constexpr (THIN) { const int tb_ = S.thin(u); dstf = tb_ >= 0; if (dstf) { const int tr_ = tb_ + (lane >> 3); \
        dstp = (const char*)g.A + ((size_t)(GATHER ? g.gidx[tr_] : tr_) * K + (lane & 7) * 8) * 2; } } } while (0)
#define PG8_TDMA(kt) do { if (wid == 0) __builtin_amdgcn_global_load_lds((const unsigned*)(tp + (size_t)(kt) * (BK * 2)), (PG8_LAS unsigned*)(lds + TS_OFF + ((kt) & 7) * 1024), 16, 0, 0); } while (0)
#define PG8_TMMA(kt) do { if constexpr (THIN) { if (thin) { const PG8_LAS unsigned char* sl_ = lds + TS_OFF + ((kt) & 7) * 1024 + troff; \
        const bf16x8 ta0 = *(const PG8_LAS bf16x8*)sl_, ta1 = *(const PG8_LAS bf16x8*)(sl_ + 64); \
        if (wr == 0) { tacc[0] = __builtin_amdgcn_mfma_f32_16x16x32_bf16(B0[0][0], ta0, tacc[0], 0, 0, 0); tacc[0] = __builtin_amdgcn_mfma_f32_16x16x32_bf16(B0[0][1], ta1, tacc[0], 0, 0, 0); \
                       tacc[1] = __builtin_amdgcn_mfma_f32_16x16x32_bf16(B1[0][0], ta0, tacc[1], 0, 0, 0); tacc[1] = __builtin_amdgcn_mfma_f32_16x16x32_bf16(B1[0][1], ta1, tacc[1], 0, 0, 0); } \
        else         { tacc[0] = __builtin_amdgcn_mfma_f32_16x16x32_bf16(B0[1][0], ta0, tacc[0], 0, 0, 0); tacc[0] = __builtin_amdgcn_mfma_f32_16x16x32_bf16(B0[1][1], ta1, tacc[0], 0, 0, 0); \
                       tacc[1] = __builtin_amdgcn_mfma_f32_16x16x32_bf16(B1[1][0], ta0, tacc[1], 0, 0, 0); tacc[1] = __builtin_amdgcn_mfma_f32_16x16x32_bf16(B1[1][1], ta1, tacc[1], 0, 0, 0); } } } } while (0)
    const char* cA = (const char*)g.A + (size_t)cur.pm * tstepA; const char* cB = (const char*)g.Bt + (size_t)cur.pn * tstepB;
    S.a_ready(cur);
    PG8_GOFFS(vAc, cur);
    PG8_TPTR(tp, thin, cur);
    if constexpr (THIN) { if (thin) { PG8_TDMA(0); PG8_TDMA(1); } }
    int vr = S.vrows(cur);
    if constexpr (SP2) {
        PG8_STAGE(PG8_SB(0, 0), cB, voffB); PG8_STAGE(PG8_SB(0, 1), cB + hstepB, voffB); PG8_STAGE(PG8_SA(0, 0), cA, vAc[0]); PG8_STAGE(PG8_SA(0, 1), cA, vAc[1]);
        if (wr == 1) PG8_BAR;
        PG8_WAIT_V(2); PG8_BAR;
        PG8_STAGE(PG8_SB(1, 0), cB + kstepB, voffB); PG8_STAGE(PG8_SA(1, 0), cA + kstep, vAc[0]); PG8_STAGE(PG8_SB(1, 1), cB + hstepB + kstepB, voffB);
        PG8_WAIT_V(6); PG8_BAR;
    } else {
        PG8_STAGE(PG8_SB(0, 0), cB, voffB); PG8_STAGE(PG8_SA(0, 0), cA, vAc[0]); PG8_STAGE(PG8_SB(0, 1), cB + hstepB, voffB); PG8_STAGE(PG8_SA(0, 1), cA, vAc[1]);
        if (wr == 1) PG8_BAR;
        PG8_WAIT_V(4); PG8_BAR;
        PG8_STAGE(PG8_SB(1, 0), cB + kstepB, voffB); PG8_STAGE(PG8_SA(1, 0), cA + kstep, vAc[0]); PG8_STAGE(PG8_SB(1, 1), cB + hstepB + kstepB, voffB);
        PG8_WAIT_V(6); PG8_BAR;
    }
    for (;;) {
        const bool has_next = S.next(ui + 1, nxt);
        const char* nA = has_next ? (const char*)g.A + (size_t)nxt.pm * tstepA : cA; const char* nB = has_next ? (const char*)g.Bt + (size_t)nxt.pn * tstepB : cB;
        if constexpr (THIN) { thinn = false; if (has_next) PG8_TPTR(tpn, thinn, nxt); }
        if constexpr (GATHER) { if (has_next) PG8_GOFFS(vAn, nxt); else { _Pragma("unroll") for (int _h = 0; _h < 2; ++_h) _Pragma("unroll") for (int _i = 0; _i < 2; ++_i) vAn[_h][_i] = vAc[_h][_i]; } }
        for (int t = 0; t < nt; t += 2) {
            const bool last = (t == nt - 2);
            const char* a1 = cA + (size_t)(t + 1) * kstep;
            const char* a2 = last ? nA : cA + (size_t)(t + 2) * kstep; const char* b2 = last ? nB : cB + (size_t)(t + 2) * kstepB;
            const char* a3 = a2 + kstep; const char* b3 = b2 + kstepB;
            unsigned vA2[2][2];
            _Pragma("unroll") for (int _h = 0; _h < 2; ++_h) _Pragma("unroll") for (int _i = 0; _i < 2; ++_i) vA2[_h][_i] = (GATHER && last) ? vAn[_h][_i] : vAc[_h][_i];
            if (last && has_next) S.a_ready(nxt);
            if constexpr (SP2) {
            PG8_LDB(B0, 0, 0); PG8_LDB(B1, 0, 1); PG8_SCHED; PG8_LDA(At, 0, 0); PG8_STAGE(PG8_SA(1, 1), a1, vAc[1]);
            PG8_WAIT_V(8); PG8_WAIT_L(0); PG8_BAR; PG8_MMA(0, 0, At, B0); PG8_MMA(0, 1, At, B1); PG8_BAR; PG8_SCHED;
            PG8_LDA(At, 0, 1); PG8_STAGE(PG8_SB(0, 0), b2, voffB); PG8_STAGE(PG8_SB(0, 1), b2 + hstepB, voffB); PG8_STAGE(PG8_SA(0, 0), a2, vA2[0]);
            PG8_WAIT_V(8); PG8_WAIT_L(0); PG8_BAR; PG8_MMA(1, 0, At, B0); PG8_MMA(1, 1, At, B1); PG8_BAR; PG8_SCHED;
            PG8_LDB(B0, 1, 0); PG8_LDB(B1, 1, 1); PG8_SCHED; PG8_LDA(At, 1, 0); PG8_STAGE(PG8_SA(0, 1), a2, vA2[1]);
            PG8_WAIT_V(8); PG8_WAIT_L(0); PG8_BAR; PG8_MMA(0, 0, At, B0); PG8_MMA(0, 1, At, B1); PG8_BAR; PG8_SCHED;
            PG8_LDA(At, 1, 1); PG8_STAGE(PG8_SB(1, 0), b3, voffB); PG8_STAGE(PG8_SB(1, 1), b3 + hstepB, voffB); PG8_STAGE(PG8_SA(1, 0), a3, vA2[0]);
            PG8_WAIT_V(8); PG8_WAIT_L(0); PG8_BAR; PG8_MMA(1, 0, At, B0); PG8_MMA(1, 1, At, B1); PG8_BAR; PG8_SCHED;
            } else {
            PG8_LDB(B0, 0, 0); PG8_SCHED; PG8_LDA(At, 0, 0); PG8_STAGE(PG8_SA(1, 1), a1, vAc[1]); if constexpr (THIN) { if (thin && !last) PG8_TDMA(t + 2); }
            PG8_WAIT_L(8); PG8_BAR; PG8_WAIT_L(0); PG8_MMA(0, 0, At, B0); PG8_BAR; PG8_SCHED;
            PG8_LDB(B1, 0, 1); PG8_STAGE(PG8_SB(0, 0), b2, voffB);
            PG8_BAR; PG8_WAIT_L(0); PG8_MMA(0, 1, At, B1); PG8_BAR;
            PG8_LDA(At, 0, 1); PG8_STAGE(PG8_SA(0, 0), a2, vA2[0]);
            PG8_BAR; PG8_WAIT_L(0); PG8_MMA(1, 0, At, B0); PG8_BAR; PG8_SCHED;
            PG8_STAGE(PG8_SB(0, 1), b2 + hstepB, voffB);
            PG8_WAIT_V(6); PG8_BAR; PG8_MMA(1, 1, At, B1); PG8_TMMA(t); PG8_BAR;
            PG8_LDB(B0, 1, 0); PG8_SCHED; PG8_LDA(At, 1, 0); PG8_STAGE(PG8_SA(0, 1), a2, vA2[1]); if constexpr (THIN) { if (thin && !last) PG8_TDMA(t + 3); }
            PG8_WAIT_L(8); PG8_BAR; PG8_WAIT_L(0); PG8_MMA(0, 0, At, B0); PG8_BAR; PG8_SCHED;
            PG8_LDB(B1, 1, 1); PG8_STAGE(PG8_SB(1, 0), b3, voffB);
            PG8_BAR; PG8_WAIT_L(0); PG8_MMA(0, 1, At, B1); PG8_BAR;
            PG8_LDA(At, 1, 1); PG8_STAGE(PG8_SA(1, 0), a3, vA2[0]);
            PG8_BAR; PG8_WAIT_L(0); PG8_MMA(1, 0, At, B0); PG8_BAR; PG8_SCHED;
            PG8_STAGE(PG8_SB(1, 1), b3 + hstepB, voffB);
            PG8_WAIT_V(6); PG8_BAR; PG8_MMA(1, 1, At, B1); PG8_TMMA(t + 1); PG8_BAR;
            }
        }
        if constexpr (PFB) { if (has_next) { const int nrow = K >> 6;
            const char* pb = nB + (size_t)(S.share(nxt) * nrow) * 4096 + lane * 64;
            for (int r = wid; r < nrow; r += 8)
                __builtin_amdgcn_global_load_lds((const unsigned*)(pb + (size_t)r * 4096), (PG8_LAS unsigned*)(lds + PFB_DUMMY), 4, 0, 0); } }
        if constexpr (ALIGN_EPI) { if (wr == 0) PG8_BAR; }
        if constexpr (!(PF & 2)) E(acc, cur, wr, wc, fr, fq);
        if constexpr (THIN) { if (thin) { E.thin(tacc, cur, wr, wc, fr, fq); tacc[0] = (f32x4){0.f, 0.f, 0.f, 0.f}; tacc[1] = (f32x4){0.f, 0.f, 0.f, 0.f}; } }
        S.done(cur);
        if (!has_next) break;
#pragma unroll
        for (int a = 0; a < 2; ++a)
#pragma unroll
            for (int b = 0; b < 2; ++b)
#pragma unroll
                for (int m = 0; m < 4; ++m)
#pragma unroll
                    for (int n = 0; n < 2; ++n) acc[a][b][m][n] = (f32x4){0.f, 0.f, 0.f, 0.f};
        cur = nxt; cA = nA; cB = nB; ++ui; vr = S.vrows(cur);
        if constexpr (THIN) { thin = thinn; tp = tpn; if (thin) { PG8_TDMA(0); PG8_TDMA(1); } }
        if constexpr (GATHER) { _Pragma("unroll") for (int _h = 0; _h < 2; ++_h) _Pragma("unroll") for (int _i = 0; _i < 2; ++_i) vAc[_h][_i] = vAn[_h][_i]; }
        if constexpr (ALIGN_EPI) { if (wr == 1) PG8_BAR; }
    }
    PG8_WAIT_V(0);
    if constexpr (!ALIGN_EPI) { if (wr == 0) PG8_BAR; }
    PG8_BAR;
#undef PG8_GOFFS
#undef PG8_TPTR
#undef PG8_TDMA
#undef PG8_TMMA
#undef PG8_SA
#undef PG8_SB
#undef PG8_STAGE
#undef PG8_LDA
#undef PG8_LDB
#undef PG8_MMA
#undef PG8_WAIT_V
#undef PG8_WAIT_L
#undef PG8_BAR
#undef PG8_SCHED
}
}

struct EpiProj {
    static constexpr bool PERM = true;
    bf16* O;
    __device__ __forceinline__ void operator()(const f32x4 (&acc)[2][2][4][2], const pg8::Unit& u, int wr, int wc, int fr, int fq) const {
        const int row0 = u.pm * 256 + wr * 64 + fr, col0 = u.pn * 256 + wc * 32 + 8 * fq;
        const float sc = u.pn < 2 ? C2 : 1.f;
#pragma unroll
        for (int ai = 0; ai < 2; ++ai)
#pragma unroll
            for (int m = 0; m < 4; ++m) { bf16* rowp = O + (size_t)(row0 + ai * 128 + m * 16) * INW + col0;
#pragma unroll
                for (int bj = 0; bj < 2; ++bj) { const f32x4 v0 = acc[ai][bj][m][0] * sc, v1 = acc[ai][bj][m][1] * sc;
                    u32x4 w; w.x = cvtpk(v0[0], v0[1]); w.y = cvtpk(v0[2], v0[3]); w.z = cvtpk(v1[0], v1[1]); w.w = cvtpk(v1[2], v1[3]);
                    *(u32x4*)(rowp + bj * 128) = w; } }
    }
};
struct EpiRes {
    static constexpr bool PERM = true;
    const float* x; const float* meta; bf16* H1;
    __device__ __forceinline__ void operator()(const f32x4 (&acc)[2][2][4][2], const pg8::Unit& u, int wr, int wc, int fr, int fq) const {
        const int row0 = u.pm * 256 + wr * 64 + fr, col0 = u.pn * 256 + wc * 32 + 8 * fq;
#pragma unroll
        for (int ai = 0; ai < 2; ++ai)
#pragma unroll
            for (int m = 0; m < 4; ++m) { const int row = row0 + ai * 128 + m * 16;
                if (row < MTOK) { const float* base = h0_row(x, meta, row) + col0; bf16* outp = H1 + (size_t)row * D + col0;
#pragma unroll
                    for (int bj = 0; bj < 2; ++bj) { const f32x4 v0 = *(const f32x4*)(base + bj * 128) + acc[ai][bj][m][0], v1 = *(const f32x4*)(base + bj * 128 + 4) + acc[ai][bj][m][1];
                        u32x4 w; w.x = cvtpk(v0[0], v0[1]); w.y = cvtpk(v0[2], v0[3]); w.z = cvtpk(v1[0], v1[1]); w.w = cvtpk(v1[2], v1[3]);
                        *(u32x4*)(outp + bj * 128) = w; } } }
    }
};
__device__ __forceinline__ float silu_mul(float g, float u) { return g * u * __builtin_amdgcn_rcpf(1.0f + __builtin_amdgcn_exp2f(-g * LOG2E)); }
struct EpiSwiGLU {
    static constexpr bool PERM = true;
    bf16* HID;
    __device__ __forceinline__ void operator()(const f32x4 (&acc)[2][2][4][2], const pg8::Unit& u, int wr, int wc, int fr, int fq) const {
        const int e = u.pm / 9, j = u.pn - e * 22;
        const int row0 = u.pm * 256 + wr * 64 + fr, col0 = j * 128 + wc * 32 + 8 * fq;
#pragma unroll
        for (int ai = 0; ai < 2; ++ai)
#pragma unroll
            for (int m = 0; m < 4; ++m) { bf16* rowp = HID + (size_t)(row0 + ai * 128 + m * 16) * FF + col0;
                const f32x4 g0 = acc[ai][0][m][0], g1 = acc[ai][0][m][1], u0 = acc[ai][1][m][0], u1 = acc[ai][1][m][1];
                u32x4 w; w.x = cvtpk(silu_mul(g0[0], u0[0]), silu_mul(g0[1], u0[1])); w.y = cvtpk(silu_mul(g0[2], u0[2]), silu_mul(g0[3], u0[3]));
                w.z = cvtpk(silu_mul(g1[0], u1[0]), silu_mul(g1[1], u1[1])); w.w = cvtpk(silu_mul(g1[2], u1[2]), silu_mul(g1[3], u1[3]));
                *(u32x4*)rowp = w; }
    }
    __device__ __forceinline__ void thin(const f32x4 (&tacc)[2], const pg8::Unit& u, int wr, int wc, int fr, int fq) const {
        const int e = u.pm / 9, j = u.pn - e * 22;
        if (fr < 8) { const f32x4 g = tacc[0], up = tacc[1];
            u32x2 w; w.x = cvtpk(silu_mul(g[0], up[0]), silu_mul(g[1], up[1])); w.y = cvtpk(silu_mul(g[2], up[2]), silu_mul(g[3], up[3]));
            *(u32x2*)(HID + (size_t)(e * CEP + 2048 + fr) * FF + j * 128 + wc * 32 + 8 * fq + 4 * wr) = w; }
    }
};
struct EpiY {
    static constexpr bool PERM = true;
    bf16* Y; const float* gate;
    __device__ __forceinline__ void operator()(const f32x4 (&acc)[2][2][4][2], const pg8::Unit& u, int wr, int wc, int fr, int fq) const {
        const int e = u.pm / 9, n4 = u.pn - e * 4;
        const int row0 = u.pm * 256 + wr * 64 + fr, col0 = n4 * 256 + wc * 32 + 8 * fq;
#pragma unroll
        for (int ai = 0; ai < 2; ++ai)
#pragma unroll
            for (int m = 0; m < 4; ++m) { const int row = row0 + ai * 128 + m * 16; const float gt = gate[row]; bf16* rowp = Y + (size_t)row * D + col0;
#pragma unroll
                for (int bj = 0; bj < 2; ++bj) { const f32x4 v0 = acc[ai][bj][m][0] * gt, v1 = acc[ai][bj][m][1] * gt;
                    u32x4 w; w.x = cvtpk(v0[0], v0[1]); w.y = cvtpk(v0[2], v0[3]); w.z = cvtpk(v1[0], v1[1]); w.w = cvtpk(v1[2], v1[3]);
                    *(u32x4*)(rowp + bj * 128) = w; } }
    }
    __device__ __forceinline__ void thin(const f32x4 (&tacc)[2], const pg8::Unit& u, int wr, int wc, int fr, int fq) const {
        const int e = u.pm / 9, n4 = u.pn - e * 4;
        if (fr < 8) { const int row = e * CEP + 2048 + fr; const float gt = gate[row];
#pragma unroll
            for (int bj = 0; bj < 2; ++bj) { const f32x4 v = tacc[bj] * gt; u32x2 w; w.x = cvtpk(v[0], v[1]); w.y = cvtpk(v[2], v[3]);
                *(u32x2*)(Y + (size_t)row * D + n4 * 256 + bj * 128 + wc * 32 + 8 * fq + 4 * wr) = w; } }
    }
};
struct Moe1Order {
    int v, vr;
    __device__ __forceinline__ bool next(int i, pg8::Unit& u) const {
        const int Lx = i * 256 + v; int e, j, ii;
        if (Lx >= 2816) return false;
        e = Lx / 176; { const int rem = Lx - e * 176; j = rem >> 3; ii = (rem + i) & 7; }
        u.pm = e * 9 + ii; u.pn = e * 22 + j; return true;
    }
    __device__ __forceinline__ int vrows(const pg8::Unit&) const { return vr; }
    __device__ __forceinline__ int share(const pg8::Unit& u) const { return u.pm % 9; }
    __device__ __forceinline__ int thin(const pg8::Unit& u) const { const int e = u.pm / 9; return (u.pm - e * 9 == 7) ? e * CEP + 2048 : -1; }
    __device__ __forceinline__ void a_ready(const pg8::Unit&) const {}
    __device__ __forceinline__ void done(const pg8::Unit&) const {}
};
struct Moe2Order {
    int v, vr;
    __device__ __forceinline__ bool next(int i, pg8::Unit& u) const {
        const int Lx = i * 256 + v; int e, n4, ii;
        if (Lx >= 512) return false;
        e = Lx >> 5; { const int rem = Lx & 31; n4 = rem >> 3; ii = (rem + i) & 7; }
        u.pm = e * 9 + ii; u.pn = e * 4 + n4; return true;
    }
    __device__ __forceinline__ int vrows(const pg8::Unit&) const { return vr; }
    __device__ __forceinline__ int share(const pg8::Unit& u) const { return u.pm % 9; }
    __device__ __forceinline__ int thin(const pg8::Unit& u) const { const int e = u.pm / 9; return (u.pm - e * 9 == 7) ? e * CEP + 2048 : -1; }
    __device__ __forceinline__ void a_ready(const pg8::Unit&) const {}
    __device__ __forceinline__ void done(const pg8::Unit&) const {}
};

template <bool DUAL, bool GATH = false, int CH = 8> __device__ __forceinline__ void skinny_mma(const bf16* A, int lda, const bf16* Bw, int Ntot, int n0, int n1, int kbeg, int kend, int lane, f32x4& acc0, f32x4& acc1, const int* gidx = nullptr) {
    const int r = lane & 15, q = lane >> 4;
    const bf16* ap = A + (size_t)(GATH ? gidx[r] : r) * lda + 8 * q;
    const bf16* b0 = Bw + (((size_t)(n0 >> 8) * Ntot + q) * 256 + (n0 & 255) + r) * 8; const bf16* b1 = DUAL ? Bw + (((size_t)(n1 >> 8) * Ntot + q) * 256 + (n1 & 255) + r) * 8 : b0;
    const size_t gstep = (size_t)4 * 256 * 8;
    acc0 = (f32x4){0.f, 0.f, 0.f, 0.f}; acc1 = (f32x4){0.f, 0.f, 0.f, 0.f};
    for (int k0 = kbeg; k0 < kend; k0 += 32 * CH) {
        bf16x8 af[CH], bf0[CH], bf1[CH];
#pragma unroll
        for (int i = 0; i < CH; ++i) { af[i] = *(const bf16x8*)(ap + k0 + i * 32); bf0[i] = *(const bf16x8*)(b0 + (size_t)(k0 / 32 + i) * gstep); if (DUAL) bf1[i] = *(const bf16x8*)(b1 + (size_t)(k0 / 32 + i) * gstep); }
#pragma unroll
        for (int i = 0; i < CH; ++i) { acc0 = __builtin_amdgcn_mfma_f32_16x16x32_bf16(bf0[i], af[i], acc0, 0, 0, 0); if (DUAL) acc1 = __builtin_amdgcn_mfma_f32_16x16x32_bf16(bf1[i], af[i], acc1, 0, 0, 0); }
    }
}
typedef GAS unsigned gu32;
#define RLX_AGENT __ATOMIC_RELAXED, __HIP_MEMORY_SCOPE_AGENT
#define LDS_WAIT() asm volatile("s_waitcnt lgkmcnt(0)" ::: "memory")
#define VM_WAIT() asm volatile("s_waitcnt vmcnt(0)" ::: "memory")
#define XB_TMO      128
#define XB_XCNT(j)  (256  + 64 * (j))
#define XB_XSUB(j)  (1280 + 64 * (j))
#define XB_XGEN(j)  (2304 + 64 * (j))
#define XB_TOP      3328
#define XB_TOPGEN   3392
#define XCD_BAR_WORDS 3456
#define XB_SPIN_CAP (1u << 18)
__device__ __forceinline__ unsigned xb_ld(unsigned* p)              { return __hip_atomic_load(p, __ATOMIC_RELAXED, __HIP_MEMORY_SCOPE_AGENT); }
__device__ __forceinline__ unsigned xb_add(unsigned* p, unsigned v) { return __hip_atomic_fetch_add(p, v, __ATOMIC_RELAXED, __HIP_MEMORY_SCOPE_AGENT); }
__device__ __forceinline__ unsigned xb_xcc_id() { return (unsigned)__builtin_amdgcn_s_getreg((3 << 11) | 20) & 0xFu; }
#define XB_SPIN(cond, bar) do { unsigned _sp = 0; while (cond) { \
    if ((++_sp & 255u) == 0u) { if (xb_ld(&(bar)[XB_TMO])) break; if (_sp > XB_SPIN_CAP) { atomicAdd(&(bar)[XB_TMO], 1u); break; } } } } while (0)
struct XcdBarrier { unsigned* bar; unsigned x; volatile LAS unsigned* st; };
__device__ __forceinline__ XcdBarrier xcd_barrier_post(unsigned* bar, volatile LAS unsigned* st) {
    XcdBarrier b; b.bar = bar; b.x = xb_xcc_id(); b.st = st;
    if (threadIdx.x == 0) (void)xb_add(&bar[XB_XCNT(b.x)], 1u);
    return b;
}
__device__ __forceinline__ void xcd_barrier_complete(unsigned* bar, unsigned x, unsigned& nloc, unsigned& nx) {
    const unsigned G = gridDim.x * gridDim.y * gridDim.z;
    unsigned sum, cnt, mine, sp = 0u;
    for (;;) {
        sum = 0u; cnt = 0u; mine = 0u;
#pragma unroll
        for (unsigned j = 0; j < 16; ++j) { const unsigned c = xb_ld(&bar[XB_XCNT(j)]); sum += c; cnt += (c > 0u) ? 1u : 0u; mine = (j == x) ? c : mine; }
        if (sum == G) break;
        __builtin_amdgcn_s_sleep(1);
        if ((++sp & 255u) == 0u) { if (xb_ld(&bar[XB_TMO])) break; if (sp > XB_SPIN_CAP) { atomicAdd(&bar[XB_TMO], 1u); break; } }
    }
    nloc = mine > 0u ? mine : 1u; nx = cnt > 0u ? cnt : 1u;
}
__device__ __forceinline__ void xcd_barrier(const XcdBarrier& b) {
    asm volatile("s_waitcnt vmcnt(0)" ::: "memory");
    __syncthreads();
    if (threadIdx.x == 0) {
        unsigned* bar = b.bar;
        __builtin_amdgcn_s_waitcnt(0);
        unsigned nloc = b.st[0], nx = b.st[1];
        if (nloc == 0u) { xcd_barrier_complete(bar, b.x, nloc, nx); b.st[0] = nloc; b.st[1] = nx; }
        const unsigned old = xb_add(&bar[XB_XSUB(b.x)], 1u);
        const unsigned gen = old / nloc;
        if (old + 1u == (gen + 1u) * nloc) {
            __builtin_amdgcn_fence(__ATOMIC_RELEASE, "agent");
            asm volatile("s_waitcnt vmcnt(0)" ::: "memory");
            const unsigned og = xb_add(&bar[XB_TOP], 1u);
            const unsigned tg = og / nx;
            if (og + 1u == (tg + 1u) * nx) xb_add(&bar[XB_TOPGEN], 1u);
            else XB_SPIN(xb_ld(&bar[XB_TOPGEN]) == tg, bar);
            __builtin_amdgcn_fence(__ATOMIC_ACQUIRE, "agent");
            xb_add(&bar[XB_XGEN(b.x)], 1u);
            asm volatile("s_waitcnt vmcnt(0)" ::: "memory");
        } else {
            XB_SPIN(xb_ld(&bar[XB_XGEN(b.x)]) == gen, bar);
            __builtin_amdgcn_fence(__ATOMIC_ACQUIRE, "agent");
            asm volatile("s_waitcnt vmcnt(0)" ::: "memory");
        }
    }
    __syncthreads();
}

#ifndef FLAT_BARRIER
#define FLAT_BARRIER 0
#endif
__device__ __forceinline__ void flat_barrier(unsigned* bar, unsigned& epoch) {
    asm volatile("s_waitcnt vmcnt(0)" ::: "memory");
    __syncthreads();
    ++epoch;
    if (threadIdx.x == 0) {
        __builtin_amdgcn_fence(__ATOMIC_RELEASE, "agent");
        asm volatile("s_waitcnt vmcnt(0)" ::: "memory");
        const unsigned target = epoch * gridDim.x;
        (void)xb_add(&bar[XB_TOP], 1u);
        unsigned sp = 0;
        while (xb_ld(&bar[XB_TOP]) < target) { __builtin_amdgcn_s_sleep(1);
            if ((++sp & 255u) == 0u) { if (xb_ld(&bar[XB_TMO])) break; if (sp > XB_SPIN_CAP) { atomicAdd(&bar[XB_TMO], 1u); break; } } }
        __builtin_amdgcn_fence(__ATOMIC_ACQUIRE, "agent");
        asm volatile("s_waitcnt vmcnt(0)" ::: "memory");
    }
    __syncthreads();
}
constexpr int NWAVES = 8;
constexpr int RING_BYTES = 131072, LDSCTL_OFF = 139264, MISC_OFF = LDSCTL_OFF + 320, LDS_BYTES = 147456;
constexpr int CW_BAR = 4096, CW_THIN = 8192;
constexpr int NPHASE = 9;
struct Args { const float* in[15]; float* out; unsigned char* ws; int ph_lo, ph_hi, flags, pad; };
struct Frame {
    LAS unsigned char* lds; volatile LAS unsigned* MISC; unsigned* ctl;
    int tid, lane, wave, vcu, G;
    const float *x, *meta, *g_mix, *w_in, *lam_vecs, *subln, *pool_w, *pool_scale, *w_o, *g_ffn, *router_w, *w_gate, *w_up, *w_down, *g_final;
    float* out;
    unsigned char* ws;
    __device__ __forceinline__ bf16* WIN() const { return (bf16*)(ws + WS_WIN); }
    __device__ __forceinline__ bf16* WO() const { return (bf16*)(ws + WS_WO); }
    __device__ __forceinline__ bf16* PW() const { return (bf16*)(ws + WS_PW); }
    __device__ __forceinline__ bf16* BT1() const { return (bf16*)(ws + WS_BT1); }
    __device__ __forceinline__ bf16* BT2() const { return (bf16*)(ws + WS_BT2); }
    __device__ __forceinline__ bf16* XN0() const { return (bf16*)(ws + WS_XN0); }
    __device__ __forceinline__ bf16* QKVU() const { return (bf16*)(ws + WS_QKVU); }
    __device__ __forceinline__ bf16* MIX() const { return (bf16*)(ws + WS_MIX); }
    __device__ __forceinline__ bf16* N2() const { return (bf16*)(ws + WS_N2); }
    __device__ __forceinline__ bf16* XG() const { return (bf16*)(ws + WS_XG); }
    __device__ __forceinline__ bf16* HID() const { return (bf16*)(ws + WS_HID); }
    __device__ __forceinline__ bf16* Y() const { return (bf16*)(ws + WS_Y); }
    __device__ __forceinline__ float* PART() const { return (float*)(ws + WS_PART); }
    __device__ __forceinline__ bf16* H1() const { return (bf16*)(ws + WS_H1); }
    __device__ __forceinline__ float* AFF() const { return (float*)(ws + WS_AFF); }
    __device__ __forceinline__ float* GATE() const { return (float*)(ws + WS_GATE); }
    __device__ __forceinline__ int* ROWIDX() const { return (int*)(ws + WS_ROWIDX); }
    __device__ __forceinline__ int* INV() const { return (int*)(ws + WS_INV); }
};

__device__ __forceinline__ void conv8x64(const float* src  , int ld, bf16* dst  , int lane) {
    float v[8];
#pragma unroll
    for (int j = 0; j < 8; ++j) v[j] = src[(size_t)j * ld + lane];
    u32x4 w; w.x = cvtpk(v[0], v[1]); w.y = cvtpk(v[2], v[3]); w.z = cvtpk(v[4], v[5]); w.w = cvtpk(v[6], v[7]);
    *(u32x4*)(dst + (size_t)lane * 8) = w;
}
constexpr int CT_BT1 = NE * 128 * 88, CT_BT2 = NE * 352 * 16, CT_EXPERT = CT_BT1 + CT_BT2;
__device__ __forceinline__ void conv_decode(Frame& F, int t, const float*& src, int& ld, bf16*& dst) {
    if (t < CT_BT1) { const int e = t / 11264, r = t - e * 11264, kb = r / 88, np = (r - kb * 88) * 64;
        const int up = (np >> 7) & 1, f0 = (np >> 8) * 128 + (np & 127);
        src = (up ? F.w_up : F.w_gate) + (size_t)e * D * FF + (size_t)(8 * kb) * FF + f0; ld = FF; dst = F.BT1() + (((size_t)(e * 22 + (np >> 8)) * (D / 8) + kb) * 256 + (np & 255)) * 8; }
    else { const int t2 = t - CT_BT1, e = t2 / 5632, r = t2 - e * 5632, kb = r >> 4, n0 = (r & 15) * 64;
        src = F.w_down + (size_t)e * FF * D + (size_t)(8 * kb) * D + n0; ld = D; dst = F.BT2() + (((size_t)(e * 4 + (n0 >> 8)) * (FF / 8) + kb) * 256 + (n0 & 255)) * 8; }
}
__device__ __forceinline__ void conv_expert_task(Frame& F, int t) { const float* src; int ld; bf16* dst; conv_decode(F, t, src, ld, dst); conv8x64(src, ld, dst, F.lane); }
__device__ __forceinline__ void p0b_expert_weights(Frame& F, int tstart) {
    const int NGW = F.G * NWAVES;
    for (int t = tstart; t < CT_EXPERT; t += NGW) conv_expert_task(F, t);
    __syncthreads();
}
__device__ __forceinline__ void p0_prologue(Frame& F) {
    const int gw = F.vcu * NWAVES + F.wave, NGW = F.G * NWAVES;
    constexpr int T_IN = 128 * 32, T_O = 128 * 16, T_P = 4 * 16 * 2;
    for (int t = gw; t < T_IN + T_O + T_P; t += NGW) {
        int r = t;
        if (r < T_IN) { const int kb = r >> 5, n0 = (r & 31) * 64; conv8x64(F.w_in + (size_t)(8 * kb) * INW + n0, INW, F.WIN() + (((size_t)(n0 >> 8) * (D / 8) + kb) * 256 + (n0 & 255)) * 8, F.lane); continue; }
        r -= T_IN;
        if (r < T_O) { const int kb = r >> 4, n0 = (r & 15) * 64; conv8x64(F.w_o + (size_t)(8 * kb) * D + n0, D, F.WO() + (((size_t)(n0 >> 8) * (D / 8) + kb) * 256 + (n0 & 255)) * 8, F.lane); continue; }
        r -= T_O;
        { const int g = r >> 5, kb = (r & 31) >> 1, n0 = (r & 1) * 64;
          conv8x64(F.pool_w + (size_t)g * 128 * 128 + (size_t)(8 * kb) * 128 + n0, 128, F.PW() + (size_t)g * 128 * 128 + ((size_t)kb * 128 + n0) * 8, F.lane); }
    }
    f32x4 gm[4];
#pragma unroll
    for (int j = 0; j < 4; ++j) gm[j] = ((const f32x4*)F.g_mix)[F.lane + 64 * j];
    for (int m = gw; m < MPAD; m += NGW) {
        unsigned long long* o8 = (unsigned long long*)(F.XN0() + (size_t)m * D) + F.lane;
        if (m < MTOK) {
            const f32x4* xr = (const f32x4*)h0_row(F.x, F.meta, m) + F.lane;
            f32x4 v[4]; float s = 0.f;
#pragma unroll
            for (int j = 0; j < 4; ++j) { v[j] = xr[64 * j]; s += (v[j].x * v[j].x + v[j].y * v[j].y) + (v[j].z * v[j].z + v[j].w * v[j].w); }
            const float r = 1.0f / sqrtf(wave_sum(s) * (1.f / D) + EPS);
#pragma unroll
            for (int j = 0; j < 4; ++j) { const f32x4 y = v[j] * r * gm[j]; o8[64 * j] = (unsigned long long)pk2(y.x, y.y) | ((unsigned long long)pk2(y.z, y.w) << 32); }
        } else {
#pragma unroll
            for (int j = 0; j < 4; ++j) o8[64 * j] = 0ull;
        }
    }
    { u32x4* z = (u32x4*)(F.QKVU() + (size_t)MTOK * INW); const int n = (MPAD - MTOK) * INW / 8;
      for (int i = F.vcu * 512 + F.tid; i < n; i += F.G * 512) z[i] = (u32x4){0u, 0u, 0u, 0u}; }
    { i32x4* inv = (i32x4*)F.INV(); const int n4 = MTOK * 16 / 4;
      for (int i = F.vcu * 512 + F.tid; i < n4; i += F.G * 512) inv[i] = (i32x4){-1, -1, -1, -1}; }
}

#define SBAR() __builtin_amdgcn_sched_barrier(0)
__device__ __forceinline__ int crow(int r, int hi) { return (r & 3) + 8 * (r >> 2) + 4 * hi; }
#ifndef ATT_SDEPTH
#define ATT_SDEPTH 1
#endif
constexpr float THR2 = 40.0f;
__device__ __forceinline__ int kswz(int row, int colB) { return row * 128 + (colB ^ (((row >> 1) & 7) << 4)); }
__device__ __forceinline__ int v_st(int k, int c) { const int kk = (k & ~0xC) | ((k & 4) << 1) | ((k & 8) >> 1); return ((kk >> 3) * 4 + (c >> 5)) * 512 + ((kk & 7) * 32 + (c & 31)) * 2; }
__device__ __forceinline__ int v_rd_base(int lane) { return ((lane & 3) << 3) | (((lane >> 2) & 3) << 6) | (((lane >> 4) & 1) << 5) | (((lane >> 5) & 1) << 11); }
constexpr int v_rd_off(int d0, int ks, int half) { return d0 * 512 + ks * 4096 + half * 256; }
template <int OFF> __device__ __forceinline__ s16x4 tr_read(int vb) {
    s16x4 r; asm volatile("ds_read_b64_tr_b16 %0, %1 offset:%2" : "=&v"(r) : "v"(vb), "i"(OFF) : "memory"); return r;
}
#define PV_READ8(F_, D0_) do { F_[0] = tr_read<v_rd_off(D0_, 0, 0)>(vb); F_[1] = tr_read<v_rd_off(D0_, 0, 1)>(vb); F_[2] = tr_read<v_rd_off(D0_, 1, 0)>(vb); F_[3] = tr_read<v_rd_off(D0_, 1, 1)>(vb); \
    F_[4] = tr_read<v_rd_off(D0_, 2, 0)>(vb); F_[5] = tr_read<v_rd_off(D0_, 2, 1)>(vb); F_[6] = tr_read<v_rd_off(D0_, 3, 0)>(vb); F_[7] = tr_read<v_rd_off(D0_, 3, 1)>(vb); } while (0)
#define PV_PK(Lx, Hx) (bf16x8){Lx[0], Lx[1], Lx[2], Lx[3], Hx[0], Hx[1], Hx[2], Hx[3]}
#define PV_MMA4(od, F_) do { od = __builtin_amdgcn_mfma_f32_32x32x16_bf16(pa0, PV_PK(F_[0], F_[1]), od, 0, 0, 0); od = __builtin_amdgcn_mfma_f32_32x32x16_bf16(pa1, PV_PK(F_[2], F_[3]), od, 0, 0, 0); \
    od = __builtin_amdgcn_mfma_f32_32x32x16_bf16(pa2, PV_PK(F_[4], F_[5]), od, 0, 0, 0); od = __builtin_amdgcn_mfma_f32_32x32x16_bf16(pa3, PV_PK(F_[6], F_[7]), od, 0, 0, 0); } while (0)
__device__ __forceinline__ void pv_pre(s16x4 (&fa)[8], s16x4 (&fb)[8], int vb) { PV_READ8(fa, 0); }
__device__ __forceinline__ void pv_main(f32x16* o, s16x4 (&fa)[8], s16x4 (&fb)[8], int vb, bf16x8 pa0, bf16x8 pa1, bf16x8 pa2, bf16x8 pa3) {
    PV_READ8(fb, 1); asm volatile("s_waitcnt lgkmcnt(8)" ::: "memory"); SBAR(); PV_MMA4(o[0], fa);
    PV_READ8(fa, 2); asm volatile("s_waitcnt lgkmcnt(8)" ::: "memory"); SBAR(); PV_MMA4(o[1], fb);
    PV_READ8(fb, 3); asm volatile("s_waitcnt lgkmcnt(8)" ::: "memory"); SBAR(); PV_MMA4(o[2], fa);
    asm volatile("s_waitcnt lgkmcnt(0)" ::: "memory"); SBAR(); PV_MMA4(o[3], fb);
}
__device__ __forceinline__ void pv_d0(f32x16* o, int vb, bf16x8 pa0, bf16x8 pa1, bf16x8 pa2, bf16x8 pa3) {
    s16x4 fa[8], fb[8]; pv_pre(fa, fb, vb); pv_main(o, fa, fb, vb, pa0, pa1, pa2, pa3);
}
template <int MODE> __device__ __forceinline__ void qkt(f32x16& p0, f32x16& p1, const LAS unsigned char* Kmap, const LAS bf16x8* qs, int r32, int hi, float sg  ) {
    if (MODE == 0) { p0 = f32x16{}; p1 = f32x16{}; }
    else { asm volatile("" : "+v"(sg));
#pragma unroll
        for (int r = 0; r < 16; ++r) { const float c = sg * (float)((r & 3) + 8 * (r >> 2)); p0[r] = c; p1[r] = c; } }
#pragma unroll
    for (int d0 = 0; d0 < 4; ++d0) { const int cb = (d0 * 16 + hi * 8) * 2;
        const bf16x8 b0 = *(const LAS bf16x8*)(Kmap + kswz(r32, cb));
        const bf16x8 b1 = *(const LAS bf16x8*)(Kmap + kswz(32 + r32, cb));
        const bf16x8 qf = qs[d0 * 64];
        p0 = __builtin_amdgcn_mfma_f32_32x32x16_bf16(b0, qf, p0, 0, 0, 0); p1 = __builtin_amdgcn_mfma_f32_32x32x16_bf16(b1, qf, p1, 0, 0, 0); }
}
__device__ __forceinline__ float max3f(float a, float b, float c) { float r; asm("v_max3_f32 %0, %1, %2, %3" : "=v"(r) : "v"(a), "v"(b), "v"(c)); return r; }
__device__ __forceinline__ void partialSM_lin(f32x16& p0, f32x16& p1, float& m_reg, float& mn, float& alpha, float a0, float a1) {
    float x0 = max3f(p0[0], p0[1], p0[2]), x1 = max3f(p1[0], p1[1], p1[2]);
#pragma unroll
    for (int r = 3; r < 15; r += 2) { x0 = max3f(x0, p0[r], p0[r + 1]); x1 = max3f(x1, p1[r], p1[r + 1]); }
    x0 = fmaxf(x0, p0[15]); x1 = fmaxf(x1, p1[15]);
    float pmax = fmaxf(x0 + a0, x1 + a1);
    { auto rr = __builtin_amdgcn_permlane32_swap(__float_as_uint(pmax), __float_as_uint(pmax), false, false);
      pmax = fmaxf(__uint_as_float(rr[0]), __uint_as_float(rr[1])); }
    if (__builtin_expect(__all(pmax - m_reg <= THR2), 1)) { mn = m_reg; alpha = 1.f; }
    else { mn = fmaxf(m_reg, pmax); alpha = __builtin_amdgcn_exp2f(m_reg - mn); m_reg = mn; }
    const float s0 = mn - a0, s1 = mn - a1;
#pragma unroll
    for (int r = 0; r < 16; ++r) { p0[r] -= s0; p1[r] -= s1; }
#pragma unroll
    for (int r = 0; r < 16; ++r) p0[r] = __builtin_amdgcn_exp2f(p0[r]);
}
__device__ __forceinline__ void partialSM(f32x16& p0, f32x16& p1, float& m_reg, float& mn, float& alpha, float dq, float nslope, int kbase  , bool masktile  ) {
#pragma unroll
    for (int r = 0; r < 16; ++r) { const float c = (float)((r & 3) + 8 * (r >> 2));
        p0[r] = fmaf(nslope, fabsf(dq - c), p0[r]); p1[r] = fmaf(nslope, fabsf(dq - (c + 32.f)), p1[r]); }
    if (masktile) {
#pragma unroll
        for (int r = 0; r < 16; ++r) { const int key = kbase + (r & 3) + 8 * (r >> 2); if (key >= L) p0[r] = -1e30f; if (key + 32 >= L) p1[r] = -1e30f; }
    }
    float pmax = p0[0];
#pragma unroll
    for (int r = 1; r < 16; ++r) pmax = fmaxf(pmax, p0[r]);
#pragma unroll
    for (int r = 0; r < 16; ++r) pmax = fmaxf(pmax, p1[r]);
    { auto rr = __builtin_amdgcn_permlane32_swap(__float_as_uint(pmax), __float_as_uint(pmax), false, false);
      pmax = fmaxf(__uint_as_float(rr[0]), __uint_as_float(rr[1])); }
    if (__builtin_expect(__all(pmax - m_reg <= THR2), 1)) { mn = m_reg; alpha = 1.f; }
    else { mn = fmaxf(m_reg, pmax); alpha = __builtin_amdgcn_exp2f(m_reg - mn); m_reg = mn; }
#pragma unroll
    for (int r = 0; r < 16; ++r) { p0[r] -= mn; p1[r] -= mn; }
#pragma unroll
    for (int r = 0; r < 16; ++r) p0[r] = __builtin_amdgcn_exp2f(p0[r]);
}
#define PK4(P, BASE, OUT) do { u32x4 w_ = {cvtpk(P[BASE + 0], P[BASE + 1]), cvtpk(P[BASE + 2], P[BASE + 3]), cvtpk(P[BASE + 4], P[BASE + 5]), cvtpk(P[BASE + 6], P[BASE + 7])}; \
    OUT = *reinterpret_cast<bf16x8*>(&w_); } while (0)
__device__ __forceinline__ void finish_p1(f32x16& q1, float ps, float alpha, float& l_reg, bf16x8& pa2, bf16x8& pa3) {
#pragma unroll
    for (int r = 0; r < 16; ++r) q1[r] = __builtin_amdgcn_exp2f(q1[r]);
#pragma unroll
    for (int r = 0; r < 16; ++r) ps += q1[r];
    { auto rr = __builtin_amdgcn_permlane32_swap(__float_as_uint(ps), __float_as_uint(ps), false, false);
      ps = __uint_as_float(rr[0]) + __uint_as_float(rr[1]); }
    l_reg = l_reg * alpha + ps;
    PK4(q1, 0, pa2); PK4(q1, 8, pa3);
}
__device__ __forceinline__ void pack_p0(f32x16& c0, float& ps, bf16x8& pa0, bf16x8& pa1) {
    float t = 0.f;
#pragma unroll
    for (int r = 0; r < 16; ++r) t += c0[r];
    ps = t;
    PK4(c0, 0, pa0); PK4(c0, 8, pa1);
}
#define MF32(A_, B_, C_) __builtin_amdgcn_mfma_f32_32x32x16_bf16(A_, B_, C_, 0, 0, 0)
#define LGKM(N) asm volatile("s_waitcnt lgkmcnt(" #N ")" ::: "memory")
__device__ __forceinline__ void step_lin(f32x16* o, const LAS unsigned char* Kmap, const LAS bf16x8* qs, int vb, int r32, int hi, float sg, float a0, float a1,
        f32x16& q1, float psP, float alP, float& l_reg, bf16x8 paP0, bf16x8 paP1,
        f32x16& c1, float& psC, float& alC, bf16x8& paC0, bf16x8& paC1, float& m_reg) {
    s16x4 fa[8], fb[8]; bf16x8 pa2, pa3, kA0, kA1, qA, kB0, kB1, qB; f32x16 c0, ci0, ci1;
    { const float b0 = a0 - m_reg, b1 = a1 - m_reg;
      asm volatile("" : "+v"(sg));
#pragma unroll
      for (int r = 0; r < 16; ++r) { const float cr = (float)((r & 3) + 8 * (r >> 2)); ci0[r] = fmaf(sg, cr, b0); ci1[r] = fmaf(sg, cr, b1); } }
#define KQ_READ(d0, k0_, k1_, q_) do { const int cb_ = ((d0) * 16 + hi * 8) * 2; k0_ = *(const LAS bf16x8*)(Kmap + kswz(r32, cb_)); k1_ = *(const LAS bf16x8*)(Kmap + kswz(32 + r32, cb_)); q_ = qs[(d0) * 64]; } while (0)
#define EX(r) q1[r] = __builtin_amdgcn_exp2f(q1[r])
#define AD(r) ps += q1[r]
    float ps = psP;
    KQ_READ(0, kA0, kA1, qA);
    SBAR();
    c0 = MF32(kA0, qA, ci0); KQ_READ(1, kB0, kB1, qB); EX(0); EX(1); EX(2); SBAR();
    c1 = MF32(kA1, qA, ci1); EX(3); EX(4); EX(5); AD(0); AD(1); AD(2); SBAR();
    c0 = MF32(kB0, qB, c0); KQ_READ(2, kA0, kA1, qA); EX(6); EX(7); EX(8); AD(3); AD(4); AD(5); SBAR();
    c1 = MF32(kB1, qB, c1); EX(9); EX(10); AD(6); AD(7); PK4(q1, 0, pa2); SBAR();
    c0 = MF32(kA0, qA, c0); KQ_READ(3, kB0, kB1, qB); EX(11); EX(12); EX(13); AD(8); AD(9); AD(10); SBAR();
    c1 = MF32(kA1, qA, c1); EX(14); EX(15); AD(11); AD(12); AD(13); PK4(q1, 8, pa3); SBAR();
    c0 = MF32(kB0, qB, c0); PV_READ8(fa, 0); AD(14); AD(15);
    { auto rr = __builtin_amdgcn_permlane32_swap(__float_as_uint(ps), __float_as_uint(ps), false, false);
      ps = __uint_as_float(rr[0]) + __uint_as_float(rr[1]); }
    l_reg = l_reg * alP + ps; asm volatile("" : "+v"(l_reg)); SBAR();
    c1 = MF32(kB1, qB, c1); PV_READ8(fb, 1); SBAR();
#undef KQ_READ
#undef EX
#undef AD
#define RD2(F_, D0_, K_) do { F_[2 * (K_)] = tr_read<v_rd_off(D0_, K_, 0)>(vb); F_[2 * (K_) + 1] = tr_read<v_rd_off(D0_, K_, 1)>(vb); } while (0)
#define PVM(d, k, F_, PA_) o[d] = MF32(PA_, PV_PK(F_[2 * (k)], F_[2 * (k) + 1]), o[d])
    float x0, x1, t = 0.f;
#define MX_HEAD(X, C) asm("v_max3_f32 %0, %1, %2, %3\n\tv_max3_f32 %0, %0, %4, %5\n\tv_max3_f32 %0, %0, %6, %7\n\tv_max3_f32 %0, %0, %8, %9" : "=&v"(X) : "v"(C[0]), "v"(C[1]), "v"(C[2]), "v"(C[3]), "v"(C[4]), "v"(C[5]), "v"(C[6]), "v"(C[7]), "v"(C[8]))
#define MX_TAIL(X, C) asm("v_max3_f32 %0, %0, %1, %2\n\tv_max3_f32 %0, %0, %3, %4\n\tv_max3_f32 %0, %0, %5, %6\n\tv_max_f32 %0, %0, %7" : "+v"(X) : "v"(C[9]), "v"(C[10]), "v"(C[11]), "v"(C[12]), "v"(C[13]), "v"(C[14]), "v"(C[15]))
    LGKM(14); SBAR(); PVM(0, 0, fa, paP0); RD2(fa, 2, 0); MX_HEAD(x0, c0); SBAR();
    LGKM(14); SBAR(); PVM(0, 1, fa, paP1); RD2(fa, 2, 1); MX_TAIL(x0, c0); SBAR();
    LGKM(14); SBAR(); PVM(0, 2, fa, pa2); RD2(fa, 2, 2); MX_HEAD(x1, c1); SBAR();
    LGKM(14); SBAR(); PVM(0, 3, fa, pa3); RD2(fa, 2, 3); MX_TAIL(x1, c1); SBAR();
#undef MX_HEAD
#undef MX_TAIL
    LGKM(14); SBAR(); PVM(1, 0, fb, paP0); RD2(fb, 3, 0);
    { float pmax = fmaxf(x0, x1);
      { auto rr = __builtin_amdgcn_permlane32_swap(__float_as_uint(pmax), __float_as_uint(pmax), false, false);
        pmax = fmaxf(__uint_as_float(rr[0]), __uint_as_float(rr[1])); }
      alC = 1.f;
      if (__builtin_expect(!__all(pmax <= THR2), 0)) {
          const float dl = fmaxf(pmax, 0.f);
          alC = __builtin_amdgcn_exp2f(-dl); m_reg += dl;
#pragma unroll
          for (int r = 0; r < 16; ++r) { c0[r] -= dl; c1[r] -= dl; }
          asm volatile("" : "+v"(c0), "+v"(c1));
      } }
    SBAR();
#define SE(i) do { c0[2 * (i)] = __builtin_amdgcn_exp2f(c0[2 * (i)]); c0[2 * (i) + 1] = __builtin_amdgcn_exp2f(c0[2 * (i) + 1]); } while (0)
#define SA(i) do { t += c0[2 * (i)]; t += c0[2 * (i) + 1]; } while (0)
    LGKM(14); SBAR(); PVM(1, 1, fb, paP1); RD2(fb, 3, 1); SE(0); SBAR();
    LGKM(14); SBAR(); PVM(1, 2, fb, pa2); RD2(fb, 3, 2); SE(1); SBAR();
    LGKM(14); SBAR(); PVM(1, 3, fb, pa3); RD2(fb, 3, 3); SE(2); SA(0); SBAR();
    LGKM(14); SBAR(); PVM(2, 0, fa, paP0); SE(3); SA(1); SBAR();
    LGKM(12); SBAR(); PVM(2, 1, fa, paP1); SE(4); SA(2); SBAR();
    LGKM(10); SBAR(); PVM(2, 2, fa, pa2); SE(5); SA(3); SBAR();
    LGKM(8); SBAR(); PVM(2, 3, fa, pa3); SE(6); SA(4); SBAR();
    LGKM(6); SBAR(); PVM(3, 0, fb, paP0); SE(7); SA(5); SBAR();
    LGKM(4); SBAR(); PVM(3, 1, fb, paP1); SA(6); SA(7); PK4(c0, 0, paC0); SBAR();
    LGKM(2); SBAR(); PVM(3, 2, fb, pa2); PK4(c0, 8, paC1); SBAR();
    LGKM(0); SBAR(); PVM(3, 3, fb, pa3); psC = t; asm volatile("" :: "v"(psC), "v"(paC0), "v"(paC1), "v"(alC)); SBAR();
#undef SE
#undef SA
#undef RD2
#undef PVM
}
constexpr int ATT_V = 0  , ATT_K = 49152  , ATT_WS = 98304, ATT_Q = 102400  , ATT_CB = 0;
constexpr int NT_ATT = 66;
template <int ABL> __device__ __forceinline__ void attn_unit(Frame& F, int b, int h, int t0, float lam, int j0, int NT, int part, int& ctask) {
    const int tid = F.tid, lane = F.lane, wid = F.wave, r32 = lane & 31, hi = lane >> 5, map = wid >> 2, wq = wid & 3;
    LAS unsigned char* lds = F.lds;
    LAS float* wsf = (LAS float*)(lds + ATT_WS) + wid * 64; LAS float* li_l = wsf; LAS float* al_l = wsf + 32;
    const float slope2 = exp2f(-2.0f * (float)(h + 1)) * LOG2E;
    const float nslope = -slope2;
    const int trow = t0 + 32 * wq + r32;
    const int trow_ld = trow < L ? trow : L - 1;
    LAS bf16x8* qr = (LAS bf16x8*)(lds + ATT_Q) + wid * 256 + lane;
    const char* Kg = (const char*)(F.QKVU() + ((size_t)b * L + (size_t)j0 * 64) * INW + COL_K1 + h * DQK);
    const char* Vg = (const char*)(F.QKVU() + ((size_t)b * L + (size_t)j0 * 64) * INW + COL_V + h * DV);
    unsigned dk, dv0, dv1;
    { const int row = 8 * wid + (lane >> 3), c = (lane & 7) ^ ((row >> 1) & 7); dk = (unsigned)(row * INW + c * 8) * 2u; }
    { const int kk = 8 * wid + ((lane & 31) >> 2), k = (kk & ~0xC) | ((kk & 4) << 1) | ((kk & 8) >> 1), cb = lane >> 5, c8 = (lane & 3) * 8;
      dv0 = (unsigned)(k * INW + cb * 32 + c8) * 2u; dv1 = (unsigned)(k * INW + (2 + cb) * 32 + c8) * 2u; }
    const unsigned wl = (unsigned)wid * 1024u;
    constexpr size_t TSTR = (size_t)64 * INW * 2;
#define DMA16(gp, off) if (!(ABL & 8)) __builtin_amdgcn_global_load_lds((const unsigned*)(gp), (LAS unsigned*)(lds + (off)), 16, 0, 0)
#define DMA_K(t, slot) do { const char* g_ = Kg + (size_t)(t) * TSTR; DMA16(g_ + dk, ATT_K + (slot) + wl); DMA16(g_ + 512 + dk, ATT_K + (slot) + 8192 + wl); } while (0)
#define DMA_V(t, slot) do { const char* g_ = Vg + (size_t)(t) * TSTR; DMA16(g_ + dv0, ATT_V + (slot) + 2 * wl); DMA16(g_ + dv1, ATT_V + (slot) + 2 * wl + 1024); } while (0)
    const int vb0 = (int)(unsigned)(uintptr_t)(lds + ATT_V) + v_rd_base(lane);
    const LAS unsigned char* Kmap0 = lds + ATT_K + map * 8192;
    const float qposf = (float)(trow - 64 * j0 - 4 * hi);
    const int kb0 = 64 * j0 + 4 * hi;
    float m_reg = -1e30f, l_reg = 0.f; f32x16 o[4] = {};
#define RESC(a) do { if (__any((a) < 1.f)) { if (hi == 0) al_l[r32] = (a); asm volatile("s_waitcnt lgkmcnt(0)" ::: "memory"); \
    _Pragma("unroll") for (int d = 0; d < 4; ++d) _Pragma("unroll") for (int r = 0; r < 16; ++r) o[d][r] *= al_l[crow(r, hi)]; } } while (0)
#define DQ(j) (qposf - (float)(64 * (j)))
#define KB(j) (kb0 + 64 * (j))
    const int r0w = t0 + 32 * wq - 64 * j0;
#define TMODE(j) ((64 * (j0 + (j)) + 64 > L) ? 0 : (r0w >= 64 * (j) + 64) ? 1 : (r0w + 31 < 64 * (j)) ? 2 : 0)
#define STEP_LIN(X, Y, j, sg_) do { const float dq_ = DQ(j); step_lin(o, Kmap0 + s0, qr, vb0 + s2, r32, hi, sg_, -(sg_) * dq_, -(sg_) * (dq_ - 32.f), \
        p1##X, ps##X, al##X, l_reg, pa##X##0, pa##X##1, p1##Y, ps##Y, al##Y, pa##Y##0, pa##Y##1, m_reg); } while (0)
#define STEP_GEN(X, Y, j, sg_) do { f32x16 c0_; float mn_; bf16x8 pa2_, pa3_; SBAR(); qkt<0>(c0_, p1##Y, Kmap0 + s0, qr, r32, hi, sg_); finish_p1(p1##X, ps##X, al##X, l_reg, pa2_, pa3_); \
        pv_d0(o, vb0 + s2, pa##X##0, pa##X##1, pa2_, pa3_); partialSM(c0_, p1##Y, m_reg, mn_, al##Y, DQ(j), nslope, KB(j), 64 * (j0 + (j)) + 64 > L); pack_p0(c0_, ps##Y, pa##Y##0, pa##Y##1); } while (0)
#define STEP_M(M, X, Y, j, sg_) do { if (M == 1) STEP_LIN(X, Y, j, sg_); else STEP_GEN(X, Y, j, sg_); } while (0)
#define WAITBAR(N) asm volatile("s_waitcnt vmcnt(" #N ") lgkmcnt(0)\n\ts_barrier" ::: "memory")
#define ENDW(i) do { if ((i) + 2 < NT) WAITBAR(4); else if ((i) + 1 < NT) WAITBAR(2); else WAITBAR(0); } while (0)
#define ROT() do { const int t_ = s0; s0 = s1; s1 = s2; s2 = t_; } while (0)
    f32x16 p1A, p1B; float psA, psB, alA, alB; bf16x8 paA0, paA1, paB0, paB1;
    int s0 = 0, s1 = 16384, s2 = 32768;
    DMA_K(0, s0); DMA_V(0, s0); DMA_K(1, s1);
    { const bf16* Qw = F.QKVU() + ((size_t)b * L + trow_ld) * INW + map * 256 + h * DQK + hi * 8;
#pragma unroll
      for (int d0 = 0; d0 < 4; ++d0) qr[d0 * 64] = *(const bf16x8*)(Qw + d0 * 16); }
    WAITBAR(0);
    DMA_K(2, s2); DMA_V(1, s1);
    { const int md_ = TMODE(0); const float sg_ = md_ == 1 ? slope2 : nslope; f32x16 c0_; float mn_; const float dq_ = DQ(0);
      if (md_ != 0) { qkt<1>(c0_, p1A, Kmap0 + s0, qr, r32, hi, sg_); partialSM_lin(c0_, p1A, m_reg, mn_, alA, -sg_ * dq_, -sg_ * (dq_ - 32.f)); }
      else { qkt<0>(c0_, p1A, Kmap0 + s0, qr, r32, hi, sg_); partialSM(c0_, p1A, m_reg, mn_, alA, dq_, nslope, KB(0), 64 * j0 + 64 > L); }
      pack_p0(c0_, psA, paA0, paA1); }
    ENDW(0); ROT();
    const int adiag = (t0 + 32 * wq) >> 6;
#define SG(j) ((j0 + (j)) < adiag ? slope2 : nslope)
    float cv0 = 0.f, cv1 = 0.f, cv2 = 0.f, cv3 = 0.f, cv4 = 0.f, cv5 = 0.f, cv6 = 0.f, cv7 = 0.f; bf16* cdst;
#define CONV_LOAD() do { cdst = nullptr; if (ctask < CT_EXPERT) { const float* cs_; int cl_; conv_decode(F, ctask, cs_, cl_, cdst); \
        cv0 = cs_[lane]; cv1 = (cs_ + (size_t)cl_)[lane]; cv2 = (cs_ + (size_t)2 * cl_)[lane]; cv3 = (cs_ + (size_t)3 * cl_)[lane]; \
        cv4 = (cs_ + (size_t)4 * cl_)[lane]; cv5 = (cs_ + (size_t)5 * cl_)[lane]; cv6 = (cs_ + (size_t)6 * cl_)[lane]; cv7 = (cs_ + (size_t)7 * cl_)[lane]; } \
        ctask += 2048; } while (0)
#define CONV_STORE() do { if (cdst) { u32x4 w_; w_.x = cvtpk(cv0, cv1); w_.y = cvtpk(cv2, cv3); w_.z = cvtpk(cv4, cv5); w_.w = cvtpk(cv6, cv7); *(u32x4*)(cdst + (size_t)lane * 8) = w_; cdst = nullptr; } } while (0)
#define ENDWC(i) do { if (cdst) WAITBAR(12); else ENDW(i); } while (0)
#define PAIR_M(M, j) do { \
        if ((j) + 2 < NT) DMA_K((j) + 2, s2); DMA_V((j) + 1, s1); \
        STEP_M(M, A, B, (j), SG(j)); RESC(alB); SBAR(); CONV_STORE(); SBAR(); CONV_LOAD(); SBAR(); ENDWC(j); ROT(); \
        if ((j) + 3 < NT) DMA_K((j) + 3, s2); if ((j) + 2 < NT) DMA_V((j) + 2, s1); \
        STEP_M(M, B, A, (j) + 1, SG((j) + 1)); RESC(alA); SBAR(); CONV_STORE(); SBAR(); CONV_LOAD(); SBAR(); ENDWC((j) + 1); ROT(); } while (0)
    cdst = nullptr;
    {
        const bool allgen = part >= 0;
        const int jd = allgen ? 1 : 2 * ((adiag + 1) >> 1) - 1;
        int j = 1;
#pragma unroll 1
        for (; j + 1 < NT && j < jd; j += 2) PAIR_M(1, j);
        if (j + 1 < NT) { PAIR_M(0, j); j += 2; }
#pragma unroll 1
        for (; !allgen && j + 1 < NT - 2; j += 2) PAIR_M(1, j);
#pragma unroll 1
        for (; j + 1 < NT; j += 2) PAIR_M(0, j);
    }
    CONV_STORE();
    STEP_M(0, A, B, NT - 1, nslope);
    RESC(alB);
    WAITBAR(0); ROT();
    { bf16x8 pa2_, pa3_; finish_p1(p1B, psB, alB, l_reg, pa2_, pa3_); SBAR();
      pv_d0(o, vb0 + s2, paB0, paB1, pa2_, pa3_); }
    if (part >= 0) {
        __syncthreads();
        LAS float* CBp = (LAS float*)(lds + ATT_CB);
        if (wq == 0) {
#pragma unroll
            for (int r = 0; r < 8; ++r)
#pragma unroll
                for (int d0 = 0; d0 < 4; ++d0) CBp[(16 * map + crow(r, hi)) * 128 + d0 * 32 + r32] = o[d0][r];
            if (hi == 0 && r32 < 16) { CBp[4096 + (16 * map + r32) * 2] = m_reg; CBp[4096 + (16 * map + r32) * 2 + 1] = l_reg; }
        }
        asm volatile("s_waitcnt lgkmcnt(0)" ::: "memory");
        __syncthreads();
        { float* PB = F.PART() + (size_t)((b * NH + h) * 16 + part) * 2 * 16 * 132;
          const int mr = tid >> 4, c8 = (tid & 15) * 8;
          const f32x4 v0 = *(const LAS f32x4*)(CBp + mr * 128 + c8), v1 = *(const LAS f32x4*)(CBp + mr * 128 + c8 + 4);
          *(f32x4*)(PB + mr * 132 + c8) = v0; *(f32x4*)(PB + mr * 132 + c8 + 4) = v1;
          if ((tid & 15) == 0) { PB[mr * 132 + 128] = CBp[4096 + mr * 2]; PB[mr * 132 + 129] = CBp[4096 + mr * 2 + 1]; } }
        asm volatile("s_waitcnt vmcnt(0)" ::: "memory");
        __syncthreads();
        LAS unsigned* flag = (LAS unsigned*)(lds + ATT_WS + 2048);
        if (tid == 0) {
            __builtin_amdgcn_fence(__ATOMIC_RELEASE, "agent");
            asm volatile("s_waitcnt vmcnt(0)" ::: "memory");
            const unsigned old = __hip_atomic_fetch_add(F.ctl + CW_THIN + 64 * (b * NH + h), 1u, __ATOMIC_RELAXED, __HIP_MEMORY_SCOPE_AGENT);
            flag[0] = (old == 15u) ? 1u : 0u;
            if (old == 15u) { __builtin_amdgcn_fence(__ATOMIC_ACQUIRE, "agent"); asm volatile("s_waitcnt vmcnt(0)" ::: "memory"); }
        }
        asm volatile("s_waitcnt lgkmcnt(0)" ::: "memory");
        __syncthreads();
        if (flag[0] != 0u) {
            const int row = tid >> 5, c4 = (tid & 31) * 4;
            const float* P0 = F.PART() + (size_t)((b * NH + h) * 16) * 2 * 16 * 132 + row * 132;
            f32x4 On[2];
#pragma unroll
            for (int mp = 0; mp < 2; ++mp) {
                float mm = -1e30f;
#pragma unroll 1
                for (int p = 0; p < 16; ++p) mm = fmaxf(mm, P0[(size_t)(p * 2 + mp) * 16 * 132 + 128]);
                f32x4 acc = {0.f, 0.f, 0.f, 0.f}; float ll = 0.f;
#pragma unroll 2
                for (int p = 0; p < 16; ++p) { const float* pp = P0 + (size_t)(p * 2 + mp) * 16 * 132; const float w = exp2f(pp[128] - mm);
                    acc += w * *(const f32x4*)(pp + c4); ll += w * pp[129]; }
                On[mp] = acc * (1.0f / ll);
            }
            const f32x4 dv = On[0] - lam * On[1];
            float ss = (dv[0] * dv[0] + dv[1] * dv[1]) + (dv[2] * dv[2] + dv[3] * dv[3]);
#pragma unroll
            for (int off = 1; off < 32; off <<= 1) ss += __shfl_xor(ss, off);
            const float rs = 0.8f / sqrtf(ss * (1.f / 128.f) + EPS);
            const f32x4 gn = *(const f32x4*)(F.subln + c4);
            u32x2 w; w.x = cvtpk(dv[0] * rs * gn[0], dv[1] * rs * gn[1]); w.y = cvtpk(dv[2] * rs * gn[2], dv[3] * rs * gn[3]);
            *(u32x2*)(F.MIX() + ((size_t)b * L + t0 + row) * D + h * DV + c4) = w;
        }
        __syncthreads();
    } else {
    if (hi == 0) li_l[r32] = l_reg; asm volatile("s_waitcnt lgkmcnt(0)" ::: "memory");
    float rli[16];
#pragma unroll
    for (int r = 0; r < 16; ++r) rli[r] = __builtin_amdgcn_rcpf(li_l[crow(r, hi)]);
    __syncthreads();
    LAS float* CB = (LAS float*)(lds + ATT_CB);
    if (map == 1) {
#pragma unroll
        for (int r = 0; r < 16; ++r)
#pragma unroll
            for (int d0 = 0; d0 < 4; ++d0) CB[(32 * wq + crow(r, hi)) * 128 + d0 * 32 + r32] = lam * o[d0][r] * rli[r];
    }
    __syncthreads();
    if (map == 0) {
        float gain[4];
#pragma unroll
        for (int d0 = 0; d0 < 4; ++d0) gain[d0] = F.subln[d0 * 32 + r32] * 0.8f;
#pragma unroll
        for (int r = 0; r < 16; ++r) {
            float dv[4]; float ss = 0.f;
#pragma unroll
            for (int d0 = 0; d0 < 4; ++d0) { dv[d0] = o[d0][r] * rli[r] - CB[(32 * wq + crow(r, hi)) * 128 + d0 * 32 + r32]; ss += dv[d0] * dv[d0]; }
#pragma unroll
            for (int off = 1; off < 32; off <<= 1) ss += __shfl_xor(ss, off);
            const float rs = 1.0f / sqrtf(ss * (1.f / 128.f) + EPS);
            const int tr = t0 + 32 * wq + crow(r, hi);
            if (tr < L) { bf16* op = F.MIX() + ((size_t)b * L + tr) * D + h * DV + r32;
#pragma unroll
                for (int d0 = 0; d0 < 4; ++d0) op[d0 * 32] = (bf16)f2bf(dv[d0] * rs * gain[d0]); }
        }
    }
    __syncthreads();
    }
#undef DMA16
#undef DMA_K
#undef DMA_V
#undef WAITBAR
#undef ENDW
#undef ROT
#undef RESC
#undef DQ
#undef KB
#undef TMODE
#undef STEP_LIN
#undef STEP_GEN
#undef STEP_M
#undef SG
#undef PAIR_M
#undef CONV_LOAD
#undef CONV_STORE
#undef ENDWC
}
__device__ __forceinline__ float lam_value(const float* lv, int lane) {
    const float s1 = wave_sum(lv[lane] * lv[64 + lane]), s2 = wave_sum(lv[128 + lane] * lv[192 + lane]);
    return expf(s1) - expf(s2) + 0.2f;
}
constexpr int POOL_PITCH = 1056, POOL_HALF_BYTES = 32 * POOL_PITCH;
template <int GI> __device__ __forceinline__ void pool_group(Frame& F, const LAS unsigned char* ub, int t, int m, int tl, int q) {
    constexpr int w2 = 1 << GI, W = 2 * w2;
    int lo = t - w2; if (lo < 0) lo = 0; int hiT = t + w2; if (hiT > L) hiT = L;
    const float inv = 1.0f / (float)(hiT - lo);
    bf16x8 pf[4];
#pragma unroll
    for (int ks = 0; ks < 4; ++ks) {
        const LAS unsigned char* up = ub + (tl + 8 - w2) * POOL_PITCH + (GI * 128 + ks * 32 + 8 * q) * 2;
        float s[8];
#pragma unroll
        for (int c = 0; c < 8; ++c) s[c] = 0.f;
#pragma unroll
        for (int i = 0; i < W; ++i) { const int tt = t - w2 + i; const float f = (tt >= 0 && tt < L) ? 1.f : 0.f; const u32x4 v = *(const LAS u32x4*)(up + i * POOL_PITCH);
            s[0] += f * __uint_as_float(v.x << 16); s[1] += f * __uint_as_float(v.x & 0xffff0000u); s[2] += f * __uint_as_float(v.y << 16); s[3] += f * __uint_as_float(v.y & 0xffff0000u);
            s[4] += f * __uint_as_float(v.z << 16); s[5] += f * __uint_as_float(v.z & 0xffff0000u); s[6] += f * __uint_as_float(v.w << 16); s[7] += f * __uint_as_float(v.w & 0xffff0000u); }
        const u32x4 vc = *(const LAS u32x4*)(up + w2 * POOL_PITCH);
        u32x4 w;
        w.x = cvtpk(s[0] * inv - __uint_as_float(vc.x << 16), s[1] * inv - __uint_as_float(vc.x & 0xffff0000u));
        w.y = cvtpk(s[2] * inv - __uint_as_float(vc.y << 16), s[3] * inv - __uint_as_float(vc.y & 0xffff0000u));
        w.z = cvtpk(s[4] * inv - __uint_as_float(vc.z << 16), s[5] * inv - __uint_as_float(vc.z & 0xffff0000u));
        w.w = cvtpk(s[6] * inv - __uint_as_float(vc.w << 16), s[7] * inv - __uint_as_float(vc.w & 0xffff0000u));
        pf[ks] = *reinterpret_cast<bf16x8*>(&w);
        asm volatile("" ::: "memory");
    }
    const bf16* Wp = F.PW() + (size_t)GI * 128 * 128 + ((size_t)q * 128 + tl) * 8;
    bf16* op = F.MIX() + (size_t)m * D + 512 + GI * 128 + 4 * q;
    const float* psc = F.pool_scale + GI * 128 + 4 * q;
#pragma unroll 2
    for (int nt = 0; nt < 8; ++nt) {
        f32x4 acc = {0.f, 0.f, 0.f, 0.f};
#pragma unroll
        for (int ks = 0; ks < 4; ++ks) { const bf16x8 wf = *(const bf16x8*)(Wp + ((size_t)ks * 4 * 128 + nt * 16) * 8);
            acc = __builtin_amdgcn_mfma_f32_16x16x32_bf16(wf, pf[ks], acc, 0, 0, 0); }
        const f32x4 sc = *(const f32x4*)(psc + nt * 16);
        u32x2 w; w.x = cvtpk(acc[0] * sc[0], acc[1] * sc[1]); w.y = cvtpk(acc[2] * sc[2], acc[3] * sc[3]);
        *(u32x2*)(op + nt * 16) = w;
    }
}
__device__ __forceinline__ void p2_pool(Frame& F) {
    const int half = F.wave >> 2, gi = F.wave & 3, lane = F.lane, tl = lane & 15, q = lane >> 4, ht = F.tid & 255;
    LAS unsigned char* ub = F.lds + half * POOL_HALF_BYTES;
    constexpr int NGR = MTOK / 16;
    for (int gb = F.vcu * 2; gb < NGR; gb += F.G * 2) {
        const int g16 = gb + half; const bool valid = g16 < NGR;
        const int b = valid ? g16 / 257 : 0, t0 = valid ? (g16 - b * 257) * 16 : 0;
        const bf16* U = F.QKVU() + (size_t)b * L * INW + COL_U;
        if (valid) {
#pragma unroll
            for (int k = 0; k < 8; ++k) { const int idx = ht + 256 * k, row = idx >> 6, ch = idx & 63; int tt = t0 - 8 + row; tt = tt < 0 ? 0 : (tt >= L ? L - 1 : tt);
                const u32x4 v = *(const u32x4*)(U + (size_t)tt * INW + ch * 8); *(LAS u32x4*)(ub + row * POOL_PITCH + ch * 16) = v; }
        }
        __syncthreads();
        if (valid) { const int t = t0 + tl, m = b * L + t;
            switch (gi) { case 0: pool_group<0>(F, ub, t, m, tl, q); break; case 1: pool_group<1>(F, ub, t, m, tl, q); break;
                          case 2: pool_group<2>(F, ub, t, m, tl, q); break; default: pool_group<3>(F, ub, t, m, tl, q); break; } }
        __syncthreads();
    }
}
template <int ABL> __device__ __forceinline__ int p2_attention(Frame& F, int ctask0) {
    const float lam = lam_value(F.lam_vecs, F.lane);
    const int v = F.vcu, x = v >> 5, q = v & 31;
    int ctask = ctask0;
#pragma unroll 1
    for (int i = 0; i < 3; ++i) {
        const int bh = (i < 2) ? 2 * x + i : (v >> 4), t0 = (i < 2) ? q * 128 : 32 * 128;
        const int part = (i < 2) ? -1 : (v & 15);
        const int j0 = (i < 2) ? 0 : 4 * part, NT = (i < 2) ? NT_ATT : (part == 15 ? 6 : 4);
        attn_unit<ABL>(F, bh >> 2, bh & 3, t0, lam, j0, NT, part, ctask);
    }
    return ctask;
}

__device__ __forceinline__ void p4_norm_router(Frame& F) {
    LAS float* rwT = (LAS float*)F.lds;
    for (int idx = F.tid; idx < 16384; idx += 512) { const int d = idx >> 4, e = idx & 15; rwT[e * 1024 + d] = F.router_w[idx] * F.g_ffn[d]; }
    __syncthreads();
    const int gw = F.vcu * NWAVES + F.wave, NGW = F.G * NWAVES, lane = F.lane;
    f32x4 gf[4];
#pragma unroll
    for (int j = 0; j < 4; ++j) gf[j] = ((const f32x4*)F.g_ffn)[lane + 64 * j];
    f32x4 vn[4];
#define LDH1(dst, m_) do { const unsigned long long* xr_ = (const unsigned long long*)(F.H1() + (size_t)(m_) * D) + lane; \
        _Pragma("unroll") for (int j = 0; j < 4; ++j) { const unsigned long long w_ = xr_[64 * j]; const unsigned lo_ = (unsigned)w_, hi_ = (unsigned)(w_ >> 32); \
            dst[j].x = __uint_as_float(lo_ << 16); dst[j].y = __uint_as_float(lo_ & 0xffff0000u); dst[j].z = __uint_as_float(hi_ << 16); dst[j].w = __uint_as_float(hi_ & 0xffff0000u); } } while (0)
    if (gw < MTOK) LDH1(vn, gw);
    for (int m = gw; m < MTOK; m += NGW) {
        f32x4 v[4]; float s = 0.f;
#pragma unroll
        for (int j = 0; j < 4; ++j) { v[j] = vn[j]; s += (v[j].x * v[j].x + v[j].y * v[j].y) + (v[j].z * v[j].z + v[j].w * v[j].w); }
        if (m + NGW < MTOK) LDH1(vn, m + NGW);
        const float r = 1.0f / sqrtf(wave_sum(s) * (1.f / D) + EPS);
        unsigned long long* o8 = (unsigned long long*)(F.N2() + (size_t)m * D) + lane;
#pragma unroll
        for (int j = 0; j < 4; ++j) { const f32x4 y = v[j] * r * gf[j]; o8[64 * j] = (unsigned long long)pk2(y.x, y.y) | ((unsigned long long)pk2(y.z, y.w) << 32); }
        float pl[16];
#pragma unroll
        for (int e = 0; e < 16; ++e) { float a = 0.f;
#pragma unroll
            for (int j = 0; j < 4; ++j) { const f32x4 w = *(const LAS f32x4*)(rwT + e * 1024 + 4 * (lane + 64 * j)); a += (v[j].x * w.x + v[j].y * w.y) + (v[j].z * w.z + v[j].w * w.w); }
            pl[e] = a; asm volatile("" ::: "memory"); }
#define HALVE(N, OFF, BIT) _Pragma("unroll") for (int e = 0; e < N; ++e) { const bool up = (lane & BIT) != 0; const float snd = up ? pl[e] : pl[N + e], kp = up ? pl[N + e] : pl[e]; pl[e] = kp + __shfl_xor(snd, OFF); }
        HALVE(8, 32, 32) HALVE(4, 16, 16) HALVE(2, 8, 8) HALVE(1, 4, 4)
#undef HALVE
        float lg = pl[0]; lg += __shfl_xor(lg, 1); lg += __shfl_xor(lg, 2); lg *= r;
        const float mx = wave_max(lg);
        const float ex = expf(lg - mx);
        const float se = wave_sum(ex) * 0.25f;
        const float mine = ex / se;
        const int b = m / L, t = m - b * L;
        if ((lane & 3) == 0) F.AFF()[((size_t)b * NE + (lane >> 2)) * L + t] = mine;
    }
    __syncthreads();
}

__device__ __forceinline__ void p5_topk(Frame& F) {
    LAS unsigned* vals = (LAS unsigned*)F.lds;
    LAS unsigned* hist = vals + 4224;
    LAS unsigned* sh = hist + 256;
    const int tid = F.tid, lane = F.lane, wave = F.wave;
    for (int pb = F.vcu; pb < NB * NE; pb += F.G) {
        const int b = pb >> 4, e = pb & 15;
        const float* aff = F.AFF() + (size_t)pb * L;
        for (int i = tid; i < L; i += 512) vals[i] = __float_as_uint(aff[i]);
        if (tid == 0) { sh[0] = 0u; sh[1] = (unsigned)CAP; }
        __syncthreads();
        unsigned prefix = 0u, mask = 0u;
        for (int pass = 3; pass >= 0; --pass) {
            const int shift = pass * 8;
            if (tid < 256) hist[tid] = 0u;
            __syncthreads();
            for (int i = tid; i < L; i += 512) { const unsigned v = vals[i]; if ((v & mask) == prefix) atomicAdd((unsigned*)&hist[(v >> shift) & 255u], 1u); }
            __syncthreads();
            if (wave == 0) {
                const unsigned kk = sh[1];
                const unsigned h0 = hist[4 * lane], h1 = hist[4 * lane + 1], h2 = hist[4 * lane + 2], h3 = hist[4 * lane + 3];
                const unsigned tot = h0 + h1 + h2 + h3;
                unsigned incl = tot;
#pragma unroll
                for (int off = 1; off < 64; off <<= 1) { const unsigned o = __shfl_down(incl, off); if (lane + off < 64) incl += o; }
                const unsigned above = incl - tot;
                if (above < kk && kk <= incl) {
                    unsigned c = above; int bin; unsigned before;
                    if (c + h3 >= kk) { bin = 3; before = c; } else { c += h3; if (c + h2 >= kk) { bin = 2; before = c; } else { c += h2; if (c + h1 >= kk) { bin = 1; before = c; } else { c += h1; bin = 0; before = c; } } }
                    sh[0] = prefix | ((unsigned)(4 * lane + bin) << shift); sh[1] = kk - before;
                }
            }
            __syncthreads();
            prefix = sh[0]; mask |= 255u << shift;
            __syncthreads();
        }
        const unsigned T = prefix, need = sh[1];
        const int i0 = tid * 9; unsigned cg = 0, ce = 0;
#pragma unroll
        for (int k = 0; k < 9; ++k) { const int i = i0 + k; if (i < L) { const unsigned v = vals[i]; cg += (v > T); ce += (v == T); } }
        unsigned sg = cg, se = ce;
#pragma unroll
        for (int off = 1; off < 64; off <<= 1) { const unsigned a = __shfl_up(sg, off), c2 = __shfl_up(se, off); if (lane >= off) { sg += a; se += c2; } }
        if (lane == 63) { sh[8 + wave] = sg; sh[16 + wave] = se; }
        __syncthreads();
        unsigned bg = 0, be = 0;
        for (int w = 0; w < wave; ++w) { bg += sh[8 + w]; be += sh[16 + w]; }
        unsigned pg = bg + sg - cg, pe = be + se - ce;
#pragma unroll
        for (int k = 0; k < 9; ++k) { const int i = i0 + k; if (i < L) { const unsigned v = vals[i];
            const bool isg = v > T, ise = v == T;
            if (isg || (ise && pe < need)) { const unsigned slot = pg + (pe < need ? pe : need); const int r = b * CAP + (int)slot;
                F.ROWIDX()[e * CEP + r] = b * L + i; F.GATE()[e * CEP + r] = __uint_as_float(v); F.INV()[((size_t)b * L + i) * 16 + e] = r; }
            pg += isg; pe += ise; } }
        if (b == 0) for (int r = CE + tid; r < CEP; r += 512) { F.ROWIDX()[e * CEP + r] = 0; F.GATE()[e * CEP + r] = 0.f; }
        __syncthreads();
    }
}

__device__ __forceinline__ void p6_gather(Frame& F) {
    const int gw = F.vcu * NWAVES + F.wave, NGW = F.G * NWAVES, lane = F.lane;
    for (int r = gw; r < NE * CEP; r += NGW) {
        const int src = F.ROWIDX()[r];
        const u32x4* s = (const u32x4*)(F.N2() + (size_t)src * D); u32x4* d = (u32x4*)(F.XG() + (size_t)r * D);
        d[lane] = s[lane]; d[lane + 64] = s[lane + 64];
    }
}

__device__ __forceinline__ void p9_final(Frame& F) {
    const int gw = F.vcu * NWAVES + F.wave, NGW = F.G * NWAVES, lane = F.lane;
    f32x4 gf[4];
#pragma unroll
    for (int j = 0; j < 4; ++j) gf[j] = ((const f32x4*)F.g_final)[lane + 64 * j];
    for (int om = gw; om < NB * SEQ; om += NGW) {
        const int b = om >> 12, t = (om & 4095) + NMETA, m = b * L + t;
        f32x4 v[4];
        LDH1(v, m);
        const int myinv = F.INV()[(size_t)m * 16 + (lane & 15)];
        for (int e = 0; e < NE; ++e) { const int r = __shfl(myinv, e); if (r >= 0) {
            const unsigned long long* yr = (const unsigned long long*)(F.Y() + ((size_t)e * CEP + r) * D) + lane;
#pragma unroll
            for (int j = 0; j < 4; ++j) { const unsigned long long w = yr[64 * j]; const unsigned lo = (unsigned)w, hi = (unsigned)(w >> 32);
                v[j].x += __uint_as_float(lo << 16); v[j].y += __uint_as_float(lo & 0xffff0000u); v[j].z += __uint_as_float(hi << 16); v[j].w += __uint_as_float(hi & 0xffff0000u); } } }
        float s = 0.f;
#pragma unroll
        for (int j = 0; j < 4; ++j) s += (v[j].x * v[j].x + v[j].y * v[j].y) + (v[j].z * v[j].z + v[j].w * v[j].w);
        const float r = 1.0f / sqrtf(wave_sum(s) * (1.f / D) + EPS);
        f32x4* orow = (f32x4*)(F.out + (size_t)om * D) + lane;
#pragma unroll
        for (int j = 0; j < 4; ++j) orow[64 * j] = v[j] * r * gf[j];
    }
}

constexpr int MFULL = 16384;
__device__ __forceinline__ void p1_tail(Frame& F) {
    const int gw = F.vcu * NWAVES + F.wave, NGW = F.G * NWAVES, lane = F.lane, tok = lane & 15, q = lane >> 4;
    for (int t = gw; t < 4 * 128; t += NGW) { const int mt = t & 3, nt = t >> 2, m0 = MFULL + mt * 16, n0 = nt * 16;
        f32x4 a0, a1; skinny_mma<false>(F.XN0() + (size_t)m0 * D, D, F.WIN(), D / 8, n0, 0, 0, D, lane, a0, a1);
        const float sc = n0 < 512 ? C2 : 1.f;
        u32x2 w; w.x = cvtpk(a0[0] * sc, a0[1] * sc); w.y = cvtpk(a0[2] * sc, a0[3] * sc);
        *(u32x2*)(F.QKVU() + (size_t)(m0 + tok) * INW + n0 + 4 * q) = w; }
}
__device__ __forceinline__ void p3_tail(Frame& F) {
    const int gw = F.vcu * NWAVES + F.wave, NGW = F.G * NWAVES, lane = F.lane, tok = lane & 15, q = lane >> 4;
    for (int t = gw; t < 4 * 64; t += NGW) { const int mt = t & 3, nt = t >> 2, m0 = MFULL + mt * 16, n0 = nt * 16;
        f32x4 a0, a1; skinny_mma<false>(F.MIX() + (size_t)m0 * D, D, F.WO(), D / 8, n0, 0, 0, D, lane, a0, a1);
        const int m = m0 + tok; const f32x4 bs = *(const f32x4*)(h0_row(F.x, F.meta, m) + n0 + 4 * q);
        const f32x4 hv = bs + a0; u32x2 w; w.x = cvtpk(hv[0], hv[1]); w.y = cvtpk(hv[2], hv[3]);
        *(u32x2*)(F.H1() + (size_t)m * D + n0 + 4 * q) = w; }
}
__global__ void __launch_bounds__(NWAVES * 64, 2) mk_fwd(Args args) {
    extern __shared__ __attribute__((aligned(16))) unsigned char lds[];
    Frame F;
    F.lds = (LAS unsigned char*)lds;
    F.MISC = (volatile LAS unsigned*)(F.lds + MISC_OFF);
    F.tid = threadIdx.x; F.lane = F.tid & 63; F.wave = __builtin_amdgcn_readfirstlane(F.tid >> 6);
    F.G = gridDim.x; { const int bx = blockIdx.x; F.vcu = (F.G % 8 == 0) ? (bx % 8) * (F.G / 8) + bx / 8 : bx; }
    unsigned char* ws = args.ws;
    F.ctl = (unsigned*)(ws + WS_CTL);
    F.x = args.in[0]; F.meta = args.in[1]; F.g_mix = args.in[2]; F.w_in = args.in[3]; F.lam_vecs = args.in[4]; F.subln = args.in[5]; F.pool_w = args.in[6];
    F.pool_scale = args.in[7]; F.w_o = args.in[8]; F.g_ffn = args.in[9]; F.router_w = args.in[10]; F.w_gate = args.in[11]; F.w_up = args.in[12]; F.w_down = args.in[13]; F.g_final = args.in[14];
    F.out = args.out;
    F.ws = ws;
    for (int u = F.tid; u < (LDS_BYTES - LDSCTL_OFF) / 4; u += NWAVES * 64) ((LAS unsigned*)(F.lds + LDSCTL_OFF))[u] = 0u;
    __syncthreads();
    const int lo = args.ph_lo, hi = args.ph_hi;
    XcdBarrier bar; bar.bar = F.ctl + CW_BAR; bar.x = 0; bar.st = nullptr;
    if (!FLAT_BARRIER && hi - lo > 1) bar = xcd_barrier_post(F.ctl + CW_BAR, F.MISC + 8);
#ifndef PHASE_MASK
#define PHASE_MASK 0x7ff
#endif
#define IN(k) (((PHASE_MASK >> (k)) & 1) && lo <= (k) && (k) < hi)
    unsigned bar_epoch = 0;
#define SEAM(k) do { if (IN(k) && IN((k) + 1)) { if (FLAT_BARRIER) flat_barrier(F.ctl + CW_BAR, bar_epoch); else xcd_barrier(bar); } } while (0)
    if (IN(0)) { p0_prologue(F); } SEAM(0);
    if (IN(1)) { p1_tail(F); pg8::Gemm g{F.XN0(), F.WIN(), MFULL, INW, D, nullptr}; pg8::StaticOrder S; S.init(MFULL, INW, F.G, (int)blockIdx.x, MFULL); EpiProj E{F.QKVU()};
                 pg8::gemm_phase<EpiProj, pg8::StaticOrder, true, true>(F.lds, g, S, E); } SEAM(1);
    if (IN(2)) { p2_pool(F); const int ct = p2_attention<0>(F, F.vcu * NWAVES + F.wave); p0b_expert_weights(F, ct); } SEAM(2);
#if PROBE_ABL
    if (IN(9)) { (void)p2_attention<(PROBE_ABL & 15)>(F, (PROBE_ABL & 16) ? F.vcu * NWAVES + F.wave : (1 << 30)); }
#endif
    if (IN(3)) { p3_tail(F); pg8::Gemm g{F.MIX(), F.WO(), MFULL, D, D, nullptr}; pg8::StaticOrder S; S.init(MFULL, D, F.G, (int)blockIdx.x, MFULL); EpiRes E{F.x, F.meta, F.H1()};
                 pg8::gemm_phase<EpiRes, pg8::StaticOrder, true, true>(F.lds, g, S, E); } SEAM(3);
    if (IN(4)) { p4_norm_router(F); } SEAM(4);
    if (IN(5)) { p5_topk(F); } SEAM(5);
    if (IN(6)) { pg8::Gemm g{F.N2(), F.BT1(), NE * CEP, NE * 5632, D, F.ROWIDX()}; Moe1Order S{F.vcu, (args.flags & 1) ? 0 : 256}; EpiSwiGLU E{F.HID()};
                 pg8::gemm_phase<EpiSwiGLU, Moe1Order, true, false, true, true, true>(F.lds, g, S, E); } SEAM(6);
    if (IN(7)) { pg8::Gemm g{F.HID(), F.BT2(), NE * CEP, NE * D, FF, nullptr}; Moe2Order S{F.vcu, (args.flags & 1) ? 0 : 256}; EpiY E{F.Y(), F.GATE()};
                 pg8::gemm_phase<EpiY, Moe2Order, true, false, false, true, true>(F.lds, g, S, E); } SEAM(7);
    if (IN(8)) { p9_final(F); }
#if PROBE_PF
    if (IN(10)) { pg8::Gemm g{F.N2(), F.BT1(), NE * CEP, NE * 5632, D, F.ROWIDX()}; Moe1Order S{F.vcu, 256}; EpiSwiGLU E{F.HID()};
                  pg8::gemm_phase<EpiSwiGLU, Moe1Order, true, false, true, true, true, PROBE_PF>(F.lds, g, S, E); }
#endif
#undef IN
#undef SEAM
}

extern "C" void kernel_launch(void* const* d_in, const int* in_sizes, int n_in, void* d_out, int out_size, void* d_ws, size_t ws_size, hipStream_t stream) {
    static int grid = 0;
    if (grid == 0) {
        if (n_in != 15 || in_sizes[0] != NB * SEQ * D || out_size != NB * SEQ * D || ws_size < WS_END) {
            fprintf(stderr, "kernel_launch: shape mismatch: n_in %d in0 %d out %d ws %zu (need %zu)\n", n_in, n_in > 0 ? in_sizes[0] : -1, out_size, ws_size, (size_t)WS_END); grid = -1; return; }
        if (hipFuncSetAttribute((const void*)mk_fwd, hipFuncAttributeMaxDynamicSharedMemorySize, LDS_BYTES) != hipSuccess) { fprintf(stderr, "kernel_launch: hipFuncSetAttribute failed\n"); grid = -1; return; }
        int dev = 0, cus = 0;
        if (hipGetDevice(&dev) != hipSuccess || hipDeviceGetAttribute(&cus, hipDeviceAttributeMultiprocessorCount, dev) != hipSuccess) { grid = -1; return; }
        if (cus < 256) { fprintf(stderr, "kernel_launch: needs 256 CUs, device has %d\n", cus); grid = -1; return; }
        (void)hipGetLastError();
        grid = 256;
    }
    if (grid < 0) return;
    if (hipMemsetAsync((char*)d_ws + WS_CTL, 0, CTL_ZERO_BYTES, stream) != hipSuccess) { fprintf(stderr, "kernel_launch: memset failed\n"); return; }
    Args a{};
    for (int i = 0; i < 15; ++i) a.in[i] = (const float*)d_in[i];
    a.out = (float*)d_out; a.ws = (unsigned char*)d_ws;
#if ONE_LAUNCH
    a.ph_lo = 0; a.ph_hi = NPHASE;
    hipLaunchKernelGGL(mk_fwd, dim3(grid), dim3(NWAVES * 64), LDS_BYTES, stream, a);
#if PROBE_PHASE >= 0
    a.ph_lo = PROBE_PHASE; a.ph_hi = PROBE_PHASE + 1; a.flags = PROBE_NOMMA;
    hipLaunchKernelGGL(mk_fwd, dim3(grid), dim3(NWAVES * 64), LDS_BYTES, stream, a);
#endif
#else
    for (int p = 0; p < NPHASE; ++p) { a.ph_lo = p; a.ph_hi = p + 1; hipLaunchKernelGGL(mk_fwd, dim3(grid), dim3(NWAVES * 64), LDS_BYTES, stream, a); }
#endif
    const hipError_t le = hipPeekAtLastError();
    if (le != hipSuccess) fprintf(stderr, "kernel_launch: launch failed: %s\n", hipGetErrorName(le));
}
```

```cpp
#include <hip/hip_runtime.h>
#include <cstdio>
#include <cstdint>

#ifndef ONE_LAUNCH
#define ONE_LAUNCH 1
#endif
#ifndef PROBE_ABL
#define PROBE_ABL 0
#endif
#ifndef PROBE_NOMMA
#define PROBE_NOMMA 0
#endif
#ifndef PROBE_PF
#define PROBE_PF 0
#endif
#ifndef PROBE_PHASE
#define PROBE_PHASE -1
#endif

#define GAS __attribute__((address_space(1)))
#define LAS __attribute__((address_space(3)))
typedef unsigned short bf16;
typedef short bf16x8 __attribute__((ext_vector_type(8)));
typedef short s16x4 __attribute__((ext_vector_type(4)));
typedef float f32x2 __attribute__((ext_vector_type(2)));
typedef float f32x4 __attribute__((ext_vector_type(4)));
typedef float f32x16 __attribute__((ext_vector_type(16)));
typedef unsigned u32x4 __attribute__((ext_vector_type(4)));
typedef unsigned u32x2 __attribute__((ext_vector_type(2)));
typedef int i32x4 __attribute__((ext_vector_type(4)));

constexpr int NB = 4, SEQ = 4096, NMETA = 16, L = SEQ + NMETA, D = 1024, MTOK = NB * L, MPAD = 16640;
constexpr int NE = 16, CAP = 514, CE = NB * CAP  , CEP = 2304  , FF = 2816, INW = 2048;
constexpr int NH = 4, DQK = 64, DV = 128;
constexpr float EPS = 1e-6f;
constexpr float C2 = 0.125f * 1.4426950408889634f;
constexpr float LOG2E = 1.4426950408889634f;
constexpr int COL_Q1 = 0, COL_Q2 = 256, COL_K1 = 512, COL_K2 = 768, COL_V = 1024, COL_U = 1536;

constexpr size_t MiB = 1u << 20;
constexpr size_t WS_CTL = 0, CTL_ZERO_BYTES = 1 * MiB;
constexpr size_t WS_ROWIDX = 1 * MiB;
constexpr size_t WS_GATE = WS_ROWIDX + 256 * 1024;
constexpr size_t WS_WIN = 2 * MiB;
constexpr size_t WS_WO = 6 * MiB;
constexpr size_t WS_PW = 8 * MiB;
constexpr size_t WS_AFF = 10 * MiB;
constexpr size_t WS_INV = 12 * MiB;
constexpr size_t WS_H1 = 16 * MiB;
constexpr size_t WS_N2 = 81 * MiB;
constexpr size_t WS_BT1 = 114 * MiB;
constexpr size_t WS_BT2 = 290 * MiB;
constexpr size_t WS_C = 378 * MiB;
constexpr size_t WS_XN0 = WS_C;
constexpr size_t WS_QKVU = WS_C + 33 * MiB;
constexpr size_t WS_MIX = WS_C + 99 * MiB;
constexpr size_t WS_PART = WS_C;
constexpr size_t WS_XG = WS_C;
constexpr size_t WS_Y = WS_C;
constexpr size_t WS_HID = WS_C + 72 * MiB;
constexpr size_t WS_END = WS_HID + 198 * MiB;
static_assert(WS_MIX + (size_t)MPAD * 1024 * 2 <= WS_END && WS_HID >= WS_XG + (size_t)NE * CEP * 1024 * 2, "ws map");
static_assert(WS_H1 + (size_t)MTOK * 1024 * 4 <= WS_N2 && WS_N2 + (size_t)MTOK * 1024 * 2 <= WS_BT1, "ws map 2");
static_assert(WS_BT1 + (size_t)NE * 5632 * 1024 * 2 <= WS_BT2 && WS_BT2 + (size_t)NE * 1024 * 2816 * 2 <= WS_C, "ws map 3");
static_assert(WS_AFF + (size_t)NB * NE * L * 4 <= WS_INV && WS_INV + (size_t)MTOK * 16 * 4 <= WS_H1, "ws map 4");

__device__ __forceinline__ unsigned f2bf(float f) { unsigned u = __builtin_bit_cast(unsigned, f); return (u + 0x7fffu + ((u >> 16) & 1u)) >> 16; }
__device__ __forceinline__ unsigned pk2(float lo, float hi) { return f2bf(lo) | (f2bf(hi) << 16); }
__device__ __forceinline__ float bf2f(unsigned short b) { return __builtin_bit_cast(float, ((unsigned)b) << 16); }
__device__ __forceinline__ unsigned cvtpk(float lo, float hi) { unsigned r; asm volatile("v_cvt_pk_bf16_f32 %0, %1, %2" : "=v"(r) : "v"(lo), "v"(hi)); return r; }
__device__ __forceinline__ float wave_sum(float v) {
#pragma unroll
    for (int o = 1; o < 64; o <<= 1) v += __shfl_xor(v, o);
    return v;
}
__device__ __forceinline__ float wave_max(float v) {
#pragma unroll
    for (int o = 1; o < 64; o <<= 1) v = fmaxf(v, __shfl_xor(v, o));
    return v;
}
__device__ __forceinline__ const float* h0_row(const float* x, const float* meta, int m) {
    const int b = m / L, t = m - b * L;
    return t < NMETA ? meta + (size_t)t * D : x + ((size_t)b * SEQ + (t - NMETA)) * D;
}

namespace pg8 {
#define PG8_LAS __attribute__((address_space(3)))
typedef unsigned short bf16_t;
typedef short bf16x8 __attribute__((ext_vector_type(8)));
typedef float f32x4 __attribute__((ext_vector_type(4)));
typedef unsigned u32x4 __attribute__((ext_vector_type(4)));
constexpr int BM = 256, BK = 64, HALF = 128, HTB = HALF * BK * 2  , STAGE_BYTES = 8 * HTB, NXCD = 8, WGM = 8;
constexpr int PFB_DUMMY = 147456 - 256;

__host__ __device__ __forceinline__ int lds_byte(int r, int c) { const int st = (r >> 4) * 2 + (c >> 5), rr = r & 15, cc = c & 31, ob = rr * 64 + cc * 2; return st * 1024 + (ob ^ (((ob >> 9) & 1) << 5)); }
__host__ __device__ __forceinline__ void stage_rc(int b, int& R, int& C) { const int st = b / 1024, sb = b % 1024, swz = sb ^ (((sb >> 9) & 1) << 5); R = (st >> 1) * 16 + swz / 64; C = (st & 1) * 32 + (swz % 64) / 2; }
__host__ __device__ __forceinline__ int perm32(int rho) { const int n = rho >> 4, i = rho & 15; return 8 * (i >> 2) + 4 * n + (i & 3); }

struct Unit { int pm, pn; };
struct Gemm { const bf16_t* A; const bf16_t* Bt; int M, N, K; const int* gidx; };

struct StaticOrder {
    int nM, nN, nwg, G, c, mvalid;
    __host__ __device__ void init(int M, int N, int G_, int c_, int mvalid_) { nM = M / BM; nN = N / BM; nwg = nM * nN; G = G_; c = c_; mvalid = mvalid_; }
    __device__ __forceinline__ int vrows(const Unit& u) const { const int r = mvalid - u.pm * BM; return r < BM ? r : BM; }
    __host__ __device__ bool next(int i, Unit& u) const {
        const long Lx = (long)i * G + c; if (Lx >= nwg) return false;
        int wgid = (int)Lx; { const int q = nwg / NXCD, r = nwg % NXCD, xcd = wgid % NXCD, off = wgid / NXCD; wgid = (xcd < r ? xcd * (q + 1) : r * (q + 1) + (xcd - r) * q) + off; }
        const int nig = WGM * nN, gid = wgid / nig, fm = gid * WGM, gsz = (nM - fm) < WGM ? (nM - fm) : WGM;
        u.pm = fm + ((wgid % nig) % gsz); u.pn = (wgid % nig) / gsz; return true;
    }
    __device__ __forceinline__ void a_ready(const Unit&) const {}
    __device__ __forceinline__ void done(const Unit&) const {}
};

__device__ __forceinline__ unsigned cvt_pk_bf16(float lo, float hi) { unsigned r; asm volatile("v_cvt_pk_bf16_f32 %0, %1, %2" : "=v"(r) : "v"(lo), "v"(hi)); return r; }

template <class Epi, class Sched, bool ALIGN_EPI = false, bool SP2 = false, bool GATHER = false, bool THIN = false, bool PFB = false, int PF = 0  >
__device__ __forceinline__ void gemm_phase(PG8_LAS unsigned char* lds, const Gemm g, const Sched& S, const Epi& E) {
    const int tid = threadIdx.x, wid = __builtin_amdgcn_readfirstlane(tid >> 6), lane = tid & 63, wr = wid >> 2, wc = wid & 3, fr = lane & 15, fq = lane >> 4;
    const int K = g.K, nt = K / BK;
    unsigned voffB[2];
    unsigned vAc[2][2], vAn[2][2];
    int gR[2], gC[2];
#pragma unroll
    for (int i = 0; i < 2; ++i) { int R, C; stage_rc(tid * 16 + i * 8192, R, C); const int Rb = Epi::PERM ? ((R & ~31) + perm32(R & 31)) : R;
        gR[i] = R; gC[i] = C; voffB[i] = (unsigned)((C >> 3) * BM + Rb) * 16u;
        vAc[0][i] = (unsigned)(R * K + C) * 2u; vAc[1][i] = (unsigned)((R + HALF) * K + C) * 2u; vAn[0][i] = vAc[0][i]; vAn[1][i] = vAc[1][i]; }
    const size_t kstep = (size_t)(BK * 2);
    const size_t hstep = (size_t)HALF * K * 2;
    const size_t tstep = 2 * hstep;
    const size_t tstepA = GATHER ? 0 : tstep;
    const size_t kstepB = (size_t)8 * BM * 16, hstepB = (size_t)HALF * 16, tstepB = (size_t)K * (BM * 2);
#define PG8_GOFFS(dst, u) do { if constexpr (GATHER) { _Pragma("unroll") for (int _h = 0; _h < 2; ++_h) _Pragma("unroll") for (int _i = 0; _i < 2; ++_i) \
        dst[_h][_i] = (unsigned)(g.gidx[(u).pm * BM + _h * HALF + gR[_i]] * K + gC[_i]) * 2u; } } while (0)
    const unsigned ldsw = (unsigned)wid * 1024u;
    const int aoff = lds_byte(wr * 64 + fr, fq * 8), boff = lds_byte(wc * 32 + fr, fq * 8);
#define PG8_SA(b, h) (((b) * 2 + (h)) * HTB)
#define PG8_SB(b, h) ((4 + (b) * 2 + (h)) * HTB)
#define PG8_STAGE(bufoff, gbase, voff) do { if constexpr (!(PF & 8)) if (!((PF & 16) && (bufoff) < 4 * HTB) && !((PF & 32) && (bufoff) >= 4 * HTB)) _Pragma("unroll") for (int _i = 0; _i < 2; ++_i) \
        __builtin_amdgcn_global_load_lds((const unsigned*)((const char*)(gbase) + (voff)[_i]), (PG8_LAS unsigned*)(lds + (bufoff) + ldsw + _i * 8192), 16, 0, 0); } while (0)
#define PG8_LDA(dst, b, h) do { if constexpr (!(PF & 4)) _Pragma("unroll") for (int m = 0; m < 4; ++m) _Pragma("unroll") for (int k = 0; k < 2; ++k) dst[m][k] = *(const PG8_LAS bf16x8*)(lds + PG8_SA(b, h) + aoff + m * 2048 + k * 1024); } while (0)
#define PG8_LDB(dst, b, h) do { if constexpr (!(PF & 4)) _Pragma("unroll") for (int n = 0; n < 2; ++n) _Pragma("unroll") for (int k = 0; k < 2; ++k) dst[n][k] = *(const PG8_LAS bf16x8*)(lds + PG8_SB(b, h) + boff + n * 2048 + k * 1024); } while (0)
#define PG8_MMA(ai, bj, At, Bt) do { if (!(PF & 1) && (ai) * HALF + wr * 64 < vr) { __builtin_amdgcn_s_setprio(1); _Pragma("unroll") for (int m = 0; m < 4; ++m) _Pragma("unroll") for (int n = 0; n < 2; ++n) _Pragma("unroll") for (int k = 0; k < 2; ++k) \
        acc[ai][bj][m][n] = __builtin_amdgcn_mfma_f32_16x16x32_bf16(Bt[n][k], At[m][k], acc[ai][bj][m][n], 0, 0, 0); __builtin_amdgcn_s_setprio(0); } } while (0)
#define PG8_WAIT_V(n) asm volatile("s_waitcnt vmcnt(" #n ")" ::: "memory")
#define PG8_WAIT_L(n) asm volatile("s_waitcnt lgkmcnt(" #n ")" ::: "memory")
#define PG8_BAR __builtin_amdgcn_s_barrier()
#define PG8_SCHED __builtin_amdgcn_sched_barrier(0)
    Unit cur, nxt; int ui = 0;
    if (!S.next(0, cur)) return;
    f32x4 acc[2][2][4][2];
#pragma unroll
    for (int a = 0; a < 2; ++a)
#pragma unroll
        for (int b = 0; b < 2; ++b)
#pragma unroll
            for (int m = 0; m < 4; ++m)
#pragma unroll
                for (int n = 0; n < 2; ++n) acc[a][b][m][n] = (f32x4){0.f, 0.f, 0.f, 0.f};
    bf16x8 At[4][2] = {}, B0[2][2] = {}, B1[2][2] = {};
    f32x4 tacc[2] = {(f32x4){0.f, 0.f, 0.f, 0.f}, (f32x4){0.f, 0.f, 0.f, 0.f}}; const char* tp = nullptr; const char* tpn = nullptr; bool thin = false, thinn = false;
    constexpr int TS_OFF = STAGE_BYTES;
    const int troff = (fr & 7) * 128 + fq * 16;
#define PG8_TPTR(dstp, dstf, u) do { if constexpr (THIN) { const int tb_ = S.thin(u); dstf = tb_ >= 0; if (dstf) { const int tr_ = tb_ + (lane >> 3); \
        dstp = (const char*)g.A + ((size_t)(GATHER ? g.gidx[tr_] : tr_) * K + (lane & 7) * 8) * 2; } } } while (0)
#define PG8_TDMA(kt) do { if (wid == 0) __builtin_amdgcn_global_load_lds((const unsigned*)(tp + (size_t)(kt) * (BK * 2)), (PG8_LAS unsigned*)(lds + TS_OFF + ((kt) & 7) * 1024), 16, 0, 0); } while (0)
#define PG8_TMMA(kt) do { if constexpr (THIN) { if (thin) { const PG8_LAS unsigned char* sl_ = lds + TS_OFF + ((kt) & 7) * 1024 + troff; \
        const bf16x8 ta0 = *(const PG8_LAS bf16x8*)sl_, ta1 = *(const PG8_LAS bf16x8*)(sl_ + 64); \
        if (wr == 0) { tacc[0] = __builtin_amdgcn_mfma_f32_16x16x32_bf16(B0[0][0], ta0, tacc[0], 0, 0, 0); tacc[0] = __builtin_amdgcn_mfma_f32_16x16x32_bf16(B0[0][1], ta1, tacc[0], 0, 0, 0); \
                       tacc[1] = __builtin_amdgcn_mfma_f32_16x16x32_bf16(B1[0][0], ta0, tacc[1], 0, 0, 0); tacc[1] = __builtin_amdgcn_mfma_f32_16x16x32_bf16(B1[0][1], ta1, tacc[1], 0, 0, 0); } \
        else         { tacc[0] = __builtin_amdgcn_mfma_f32_16x16x32_bf16(B0[1][0], ta0, tacc[0], 0, 0, 0); tacc[0] = __builtin_amdgcn_mfma_f32_16x16x32_bf16(B0[1][1], ta1, tacc[0], 0, 0, 0); \
                       tacc[1] = __builtin_amdgcn_mfma_f32_16x16x32_bf16(B1[1][0], ta0, tacc[1], 0, 0, 0); tacc[1] = __builtin_amdgcn_mfma_f32_16x16x32_bf16(B1[1][1], ta1, tacc[1], 0, 0, 0); } } } } while (0)
    const char* cA = (const char*)g.A + (size_t)cur.pm * tstepA; const char* cB = (const char*)g.Bt + (size_t)cur.pn * tstepB;
    S.a_ready(cur);
    PG8_GOFFS(vAc, cur);
    PG8_TPTR(tp, thin, cur);
    if constexpr (THIN) { if (thin) { PG8_TDMA(0); PG8_TDMA(1); } }
    int vr = S.vrows(cur);
    if constexpr (SP2) {
        PG8_STAGE(PG8_SB(0, 0), cB, voffB); PG8_STAGE(PG8_SB(0, 1), cB + hstepB, voffB); PG8_STAGE(PG8_SA(0, 0), cA, vAc[0]); PG8_STAGE(PG8_SA(0, 1), cA, vAc[1]);
        if (wr == 1) PG8_BAR;
        PG8_WAIT_V(2); PG8_BAR;
        PG8_STAGE(PG8_SB(1, 0), cB + kstepB, voffB); PG8_STAGE(PG8_SA(1, 0), cA + kstep, vAc[0]); PG8_STAGE(PG8_SB(1, 1), cB + hstepB + kstepB, voffB);
        PG8_WAIT_V(6); PG8_BAR;
    } else {
        PG8_STAGE(PG8_SB(0, 0), cB, voffB); PG8_STAGE(PG8_SA(0, 0), cA, vAc[0]); PG8_STAGE(PG8_SB(0, 1), cB + hstepB, voffB); PG8_STAGE(PG8_SA(0, 1), cA, vAc[1]);
        if (wr == 1) PG8_BAR;
        PG8_WAIT_V(4); PG8_BAR;
        PG8_STAGE(PG8_SB(1, 0), cB + kstepB, voffB); PG8_STAGE(PG8_SA(1, 0), cA + kstep, vAc[0]); PG8_STAGE(PG8_SB(1, 1), cB + hstepB + kstepB, voffB);
        PG8_WAIT_V(6); PG8_BAR;
    }
    for (;;) {
        const bool has_next = S.next(ui + 1, nxt);
        const char* nA = has_next ? (const char*)g.A + (size_t)nxt.pm * tstepA : cA; const char* nB = has_next ? (const char*)g.Bt + (size_t)nxt.pn * tstepB : cB;
        if constexpr (THIN) { thinn = false; if (has_next) PG8_TPTR(tpn, thinn, nxt); }
        if constexpr (GATHER) { if (has_next) PG8_GOFFS(vAn, nxt); else { _Pragma("unroll") for (int _h = 0; _h < 2; ++_h) _Pragma("unroll") for (int _i = 0; _i < 2; ++_i) vAn[_h][_i] = vAc[_h][_i]; } }
        for (int t = 0; t < nt; t += 2) {
            const bool last = (t == nt - 2);
            const char* a1 = cA + (size_t)(t + 1) * kstep;
            const char* a2 = last ? nA : cA + (size_t)(t + 2) * kstep; const char* b2 = last ? nB : cB + (size_t)(t + 2) * kstepB;
            const char* a3 = a2 + kstep; const char* b3 = b2 + kstepB;
            unsigned vA2[2][2];
            _Pragma("unroll") for (int _h = 0; _h < 2; ++_h) _Pragma("unroll") for (int _i = 0; _i < 2; ++_i) vA2[_h][_i] = (GATHER && last) ? vAn[_h][_i] : vAc[_h][_i];
            if (last && has_next) S.a_ready(nxt);
            if constexpr (SP2) {
            PG8_LDB(B0, 0, 0); PG8_LDB(B1, 0, 1); PG8_SCHED; PG8_LDA(At, 0, 0); PG8_STAGE(PG8_SA(1, 1), a1, vAc[1]);
            PG8_WAIT_V(8); PG8_WAIT_L(0); PG8_BAR; PG8_MMA(0, 0, At, B0); PG8_MMA(0, 1, At, B1); PG8_BAR; PG8_SCHED;
            PG8_LDA(At, 0, 1); PG8_STAGE(PG8_SB(0, 0), b2, voffB); PG8_STAGE(PG8_SB(0, 1), b2 + hstepB, voffB); PG8_STAGE(PG8_SA(0, 0), a2, vA2[0]);
            PG8_WAIT_V(8); PG8_WAIT_L(0); PG8_BAR; PG8_MMA(1, 0, At, B0); PG8_MMA(1, 1, At, B1); PG8_BAR; PG8_SCHED;
            PG8_LDB(B0, 1, 0); PG8_LDB(B1, 1, 1); PG8_SCHED; PG8_LDA(At, 1, 0); PG8_STAGE(PG8_SA(0, 1), a2, vA2[1]);
            PG8_WAIT_V(8); PG8_WAIT_L(0); PG8_BAR; PG8_MMA(0, 0, At, B0); PG8_MMA(0, 1, At, B1); PG8_BAR; PG8_SCHED;
            PG8_LDA(At, 1, 1); PG8_STAGE(PG8_SB(1, 0), b3, voffB); PG8_STAGE(PG8_SB(1, 1), b3 + hstepB, voffB); PG8_STAGE(PG8_SA(1, 0), a3, vA2[0]);
            PG8_WAIT_V(8); PG8_WAIT_L(0); PG8_BAR; PG8_MMA(1, 0, At, B0); PG8_MMA(1, 1, At, B1); PG8_BAR; PG8_SCHED;
            } else {
            PG8_LDB(B0, 0, 0); PG8_SCHED; PG8_LDA(At, 0, 0); PG8_STAGE(PG8_SA(1, 1), a1, vAc[1]); if constexpr (THIN) { if (thin && !last) PG8_TDMA(t + 2); }
            PG8_WAIT_L(8); PG8_BAR; PG8_WAIT_L(0); PG8_MMA(0, 0, At, B0); PG8_BAR; PG8_SCHED;
            PG8_LDB(B1, 0, 1); PG8_STAGE(PG8_SB(0, 0), b2, voffB);
            PG8_BAR; PG8_WAIT_L(0); PG8_MMA(0, 1, At, B1); PG8_BAR;
            PG8_LDA(At, 0, 1); PG8_STAGE(PG8_SA(0, 0), a2, vA2[0]);
            PG8_BAR; PG8_WAIT_L(0); PG8_MMA(1, 0, At, B0); PG8_BAR; PG8_SCHED;
            PG8_STAGE(PG8_SB(0, 1), b2 + hstepB, voffB);
            PG8_WAIT_V(6); PG8_BAR; PG8_MMA(1, 1, At, B1); PG8_TMMA(t); PG8_BAR;
            PG8_LDB(B0, 1, 0); PG8_SCHED; PG8_LDA(At, 1, 0); PG8_STAGE(PG8_SA(0, 1), a2, vA2[1]); if constexpr (THIN) { if (thin && !last) PG8_TDMA(t + 3); }
            PG8_WAIT_L(8); PG8_BAR; PG8_WAIT_L(0); PG8_MMA(0, 0, At, B0); PG8_BAR; PG8_SCHED;
            PG8_LDB(B1, 1, 1); PG8_STAGE(PG8_SB(1, 0), b3, voffB);
            PG8_BAR; PG8_WAIT_L(0); PG8_MMA(0, 1, At, B1); PG8_BAR;
            PG8_LDA(At, 1, 1); PG8_STAGE(PG8_SA(1, 0), a3, vA2[0]);
            PG8_BAR; PG8_WAIT_L(0); PG8_MMA(1, 0, At, B0); PG8_BAR; PG8_SCHED;
            PG8_STAGE(PG8_SB(1, 1), b3 + hstepB, voffB);
            PG8_WAIT_V(6); PG8_BAR; PG8_MMA(1, 1, At, B1); PG8_TMMA(t + 1); PG8_BAR;
            }
        }
        if constexpr (PFB) { if (has_next) { const int nrow = K >> 6;
            const char* pb = nB + (size_t)(S.share(nxt) * nrow) * 4096 + lane * 64;
            for (int r = wid; r < nrow; r += 8)
                __builtin_amdgcn_global_load_lds((const unsigned*)(pb + (size_t)r * 4096), (PG8_LAS unsigned*)(lds + PFB_DUMMY), 4, 0, 0); } }
        if constexpr (ALIGN_EPI) { if (wr == 0) PG8_BAR; }
        if constexpr (!(PF & 2)) E(acc, cur, wr, wc, fr, fq);
        if constexpr (THIN) { if (thin) { E.thin(tacc, cur, wr, wc, fr, fq); tacc[0] = (f32x4){0.f, 0.f, 0.f, 0.f}; tacc[1] = (f32x4){0.f, 0.f, 0.f, 0.f}; } }
        S.done(cur);
        if (!has_next) break;
#pragma unroll
        for (int a = 0; a < 2; ++a)
#pragma unroll
            for (int b = 0; b < 2; ++b)
#pragma unroll
                for (int m = 0; m < 4; ++m)
#pragma unroll
                    for (int n = 0; n < 2; ++n) acc[a][b][m][n] = (f32x4){0.f, 0.f, 0.f, 0.f};
        cur = nxt; cA = nA; cB = nB; ++ui; vr = S.vrows(cur);
        if constexpr (THIN) { thin = thinn; tp = tpn; if (thin) { PG8_TDMA(0); PG8_TDMA(1); } }
        if constexpr (GATHER) { _Pragma("unroll") for (int _h = 0; _h < 2; ++_h) _Pragma("unroll") for (int _i = 0; _i < 2; ++_i) vAc[_h][_i] = vAn[_h][_i]; }
        if constexpr (ALIGN_EPI) { if (wr == 1) PG8_BAR; }
    }
    PG8_WAIT_V(0);
    if constexpr (!ALIGN_EPI) { if (wr == 0) PG8_BAR; }
    PG8_BAR;
#undef PG8_GOFFS
#undef PG8_TPTR
#undef PG8_TDMA
#undef PG8_TMMA
#undef PG8_SA
#undef PG8_SB
#undef PG8_STAGE
#undef PG8_LDA
#undef PG8_LDB
#undef PG8_MMA
#undef PG8_WAIT_V
#undef PG8_WAIT_L
#undef PG8_BAR
#undef PG8_SCHED
}
}

struct EpiProj {
    static constexpr bool PERM = true;
    bf16* O;
    __device__ __forceinline__ void operator()(const f32x4 (&acc)[2][2][4][2], const pg8::Unit& u, int wr, int wc, int fr, int fq) const {
        const int row0 = u.pm * 256 + wr * 64 + fr, col0 = u.pn * 256 + wc * 32 + 8 * fq;
        const float sc = u.pn < 2 ? C2 : 1.f;
#pragma unroll
        for (int ai = 0; ai < 2; ++ai)
#pragma unroll
            for (int m = 0; m < 4; ++m) { bf16* rowp = O + (size_t)(row0 + ai * 128 + m * 16) * INW + col0;
#pragma unroll
                for (int bj = 0; bj < 2; ++bj) { const f32x4 v0 = acc[ai][bj][m][0] * sc, v1 = acc[ai][bj][m][1] * sc;
                    u32x4 w; w.x = cvtpk(v0[0], v0[1]); w.y = cvtpk(v0[2], v0[3]); w.z = cvtpk(v1[0], v1[1]); w.w = cvtpk(v1[2], v1[3]);
                    *(u32x4*)(rowp + bj * 128) = w; } }
    }
};
struct EpiRes {
    static constexpr bool PERM = true;
    const float* x; const float* meta; bf16* H1;
    __device__ __forceinline__ void operator()(const f32x4 (&acc)[2][2][4][2], const pg8::Unit& u, int wr, int wc, int fr, int fq) const {
        const int row0 = u.pm * 256 + wr * 64 + fr, col0 = u.pn * 256 + wc * 32 + 8 * fq;
#pragma unroll
        for (int ai = 0; ai < 2; ++ai)
#pragma unroll
            for (int m = 0; m < 4; ++m) { const int row = row0 + ai * 128 + m * 16;
                if (row < MTOK) { const float* base = h0_row(x, meta, row) + col0; bf16* outp = H1 + (size_t)row * D + col0;
#pragma unroll
                    for (int bj = 0; bj < 2; ++bj) { const f32x4 v0 = *(const f32x4*)(base + bj * 128) + acc[ai][bj][m][0], v1 = *(const f32x4*)(base + bj * 128 + 4) + acc[ai][bj][m][1];
                        u32x4 w; w.x = cvtpk(v0[0], v0[1]); w.y = cvtpk(v0[2], v0[3]); w.z = cvtpk(v1[0], v1[1]); w.w = cvtpk(v1[2], v1[3]);
                        *(u32x4*)(outp + bj * 128) = w; } } }
    }
};
__device__ __forceinline__ float silu_mul(float g, float u) { return g * u * __builtin_amdgcn_rcpf(1.0f + __builtin_amdgcn_exp2f(-g * LOG2E)); }
struct EpiSwiGLU {
    static constexpr bool PERM = true;
    bf16* HID;
    __device__ __forceinline__ void operator()(const f32x4 (&acc)[2][2][4][2], const pg8::Unit& u, int wr, int wc, int fr, int fq) const {
        const int e = u.pm / 9, j = u.pn - e * 22;
        const int row0 = u.pm * 256 + wr * 64 + fr, col0 = j * 128 + wc * 32 + 8 * fq;
#pragma unroll
        for (int ai = 0; ai < 2; ++ai)
#pragma unroll
            for (int m = 0; m < 4; ++m) { bf16* rowp = HID + (size_t)(row0 + ai * 128 + m * 16) * FF + col0;
                const f32x4 g0 = acc[ai][0][m][0], g1 = acc[ai][0][m][1], u0 = acc[ai][1][m][0], u1 = acc[ai][1][m][1];
                u32x4 w; w.x = cvtpk(silu_mul(g0[0], u0[0]), silu_mul(g0[1], u0[1])); w.y = cvtpk(silu_mul(g0[2], u0[2]), silu_mul(g0[3], u0[3]));
                w.z = cvtpk(silu_mul(g1[0], u1[0]), silu_mul(g1[1], u1[1])); w.w = cvtpk(silu_mul(g1[2], u1[2]), silu_mul(g1[3], u1[3]));
                *(u32x4*)rowp = w; }
    }
    __device__ __forceinline__ void thin(const f32x4 (&tacc)[2], const pg8::Unit& u, int wr, int wc, int fr, int fq) const {
        const int e = u.pm / 9, j = u.pn - e * 22;
        if (fr < 8) { const f32x4 g = tacc[0], up = tacc[1];
            u32x2 w; w.x = cvtpk(silu_mul(g[0], up[0]), silu_mul(g[1], up[1])); w.y = cvtpk(silu_mul(g[2], up[2]), silu_mul(g[3], up[3]));
            *(u32x2*)(HID + (size_t)(e * CEP + 2048 + fr) * FF + j * 128 + wc * 32 + 8 * fq + 4 * wr) = w; }
    }
};
struct EpiY {
    static constexpr bool PERM = true;
    bf16* Y; const float* gate;
    __device__ __forceinline__ void operator()(const f32x4 (&acc)[2][2][4][2], const pg8::Unit& u, int wr, int wc, int fr, int fq) const {
        const int e = u.pm / 9, n4 = u.pn - e * 4;
        const int row0 = u.pm * 256 + wr * 64 + fr, col0 = n4 * 256 + wc * 32 + 8 * fq;
#pragma unroll
        for (int ai = 0; ai < 2; ++ai)
#pragma unroll
            for (int m = 0; m < 4; ++m) { const int row = row0 + ai * 128 + m * 16; const float gt = gate[row]; bf16* rowp = Y + (size_t)row * D + col0;
#pragma unroll
                for (int bj = 0; bj < 2; ++bj) { const f32x4 v0 = acc[ai][bj][m][0] * gt, v1 = acc[ai][bj][m][1] * gt;
                    u32x4 w; w.x = cvtpk(v0[0], v0[1]); w.y = cvtpk(v0[2], v0[3]); w.z = cvtpk(v1[0], v1[1]); w.w = cvtpk(v1[2], v1[3]);
                    *(u32x4*)(rowp + bj * 128) = w; } }
    }
    __device__ __forceinline__ void thin(const f32x4 (&tacc)[2], const pg8::Unit& u, int wr, int wc, int fr, int fq) const {
        const int e = u.pm / 9, n4 = u.pn - e * 4;
        if (fr < 8) { const int row = e * CEP + 2048 + fr; const float gt = gate[row];
#pragma unroll
            for (int bj = 0; bj < 2; ++bj) { const f32x4 v = tacc[bj] * gt; u32x2 w; w.x = cvtpk(v[0], v[1]); w.y = cvtpk(v[2], v[3]);
                *(u32x2*)(Y + (size_t)row * D + n4 * 256 + bj * 128 + wc * 32 + 8 * fq + 4 * wr) = w; } }
    }
};
struct Moe1Order {
    int v, vr;
    __device__ __forceinline__ bool next(int i, pg8::Unit& u) const {
        const int Lx = i * 256 + v; int e, j, ii;
        if (Lx >= 2816) return false;
        e = Lx / 176; { const int rem = Lx - e * 176; j = rem >> 3; ii = (rem + i) & 7; }
        u.pm = e * 9 + ii; u.pn = e * 22 + j; return true;
    }
    __device__ __forceinline__ int vrows(const pg8::Unit&) const { return vr; }
    __device__ __forceinline__ int share(const pg8::Unit& u) const { return u.pm % 9; }
    __device__ __forceinline__ int thin(const pg8::Unit& u) const { const int e = u.pm / 9; return (u.pm - e * 9 == 7) ? e * CEP + 2048 : -1; }
    __device__ __forceinline__ void a_ready(const pg8::Unit&) const {}
    __device__ __forceinline__ void done(const pg8::Unit&) const {}
};
struct Moe2Order {
    int v, vr;
    __device__ __forceinline__ bool next(int i, pg8::Unit& u) const {
        const int Lx = i * 256 + v; int e, n4, ii;
        if (Lx >= 512) return false;
        e = Lx >> 5; { const int rem = Lx & 31; n4 = rem >> 3; ii = (rem + i) & 7; }
        u.pm = e * 9 + ii; u.pn = e * 4 + n4; return true;
    }
    __device__ __forceinline__ int vrows(const pg8::Unit&) const { return vr; }
    __device__ __forceinline__ int share(const pg8::Unit& u) const { return u.pm % 9; }
    __device__ __forceinline__ int thin(const pg8::Unit& u) const { const int e = u.pm / 9; return (u.pm - e * 9 == 7) ? e * CEP + 2048 : -1; }
    __device__ __forceinline__ void a_ready(const pg8::Unit&) const {}
    __device__ __forceinline__ void done(const pg8::Unit&) const {}
};

template <bool DUAL, bool GATH = false, int CH = 8> __device__ __forceinline__ void skinny_mma(const bf16* A, int lda, const bf16* Bw, int Ntot, int n0, int n1, int kbeg, int kend, int lane, f32x4& acc0, f32x4& acc1, const int* gidx = nullptr) {
    const int r = lane & 15, q = lane >> 4;
    const bf16* ap = A + (size_t)(GATH ? gidx[r] : r) * lda + 8 * q;
    const bf16* b0 = Bw + (((size_t)(n0 >> 8) * Ntot + q) * 256 + (n0 & 255) + r) * 8; const bf16* b1 = DUAL ? Bw + (((size_t)(n1 >> 8) * Ntot + q) * 256 + (n1 & 255) + r) * 8 : b0;
    const size_t gstep = (size_t)4 * 256 * 8;
    acc0 = (f32x4){0.f, 0.f, 0.f, 0.f}; acc1 = (f32x4){0.f, 0.f, 0.f, 0.f};
    for (int k0 = kbeg; k0 < kend; k0 += 32 * CH) {
        bf16x8 af[CH], bf0[CH], bf1[CH];
#pragma unroll
        for (int i = 0; i < CH; ++i) { af[i] = *(const bf16x8*)(ap + k0 + i * 32); bf0[i] = *(const bf16x8*)(b0 + (size_t)(k0 / 32 + i) * gstep); if (DUAL) bf1[i] = *(const bf16x8*)(b1 + (size_t)(k0 / 32 + i) * gstep); }
#pragma unroll
        for (int i = 0; i < CH; ++i) { acc0 = __builtin_amdgcn_mfma_f32_16x16x32_bf16(bf0[i], af[i], acc0, 0, 0, 0); if (DUAL) acc1 = __builtin_amdgcn_mfma_f32_16x16x32_bf16(bf1[i], af[i], acc1, 0, 0, 0); }
    }
}
typedef GAS unsigned gu32;
#define RLX_AGENT __ATOMIC_RELAXED, __HIP_MEMORY_SCOPE_AGENT
#define LDS_WAIT() asm volatile("s_waitcnt lgkmcnt(0)" ::: "memory")
#define VM_WAIT() asm volatile("s_waitcnt vmcnt(0)" ::: "memory")
#define XB_TMO      128
#define XB_XCNT(j)  (256  + 64 * (j))
#define XB_XSUB(j)  (1280 + 64 * (j))
#define XB_XGEN(j)  (2304 + 64 * (j))
#define XB_TOP      3328
#define XB_TOPGEN   3392
#define XCD_BAR_WORDS 3456
#define XB_SPIN_CAP (1u << 18)
__device__ __forceinline__ unsigned xb_ld(unsigned* p)              { return __hip_atomic_load(p, __ATOMIC_RELAXED, __HIP_MEMORY_SCOPE_AGENT); }
__device__ __forceinline__ unsigned xb_add(unsigned* p, unsigned v) { return __hip_atomic_fetch_add(p, v, __ATOMIC_RELAXED, __HIP_MEMORY_SCOPE_AGENT); }
__device__ __forceinline__ unsigned xb_xcc_id() { return (unsigned)__builtin_amdgcn_s_getreg((3 << 11) | 20) & 0xFu; }
#define XB_SPIN(cond, bar) do { unsigned _sp = 0; while (cond) { \
    if ((++_sp & 255u) == 0u) { if (xb_ld(&(bar)[XB_TMO])) break; if (_sp > XB_SPIN_CAP) { atomicAdd(&(bar)[XB_TMO], 1u); break; } } } } while (0)
struct XcdBarrier { unsigned* bar; unsigned x; volatile LAS unsigned* st; };
__device__ __forceinline__ XcdBarrier xcd_barrier_post(unsigned* bar, volatile LAS unsigned* st) {
    XcdBarrier b; b.bar = bar; b.x = xb_xcc_id(); b.st = st;
    if (threadIdx.x == 0) (void)xb_add(&bar[XB_XCNT(b.x)], 1u);
    return b;
}
__device__ __forceinline__ void xcd_barrier_complete(unsigned* bar, unsigned x, unsigned& nloc, unsigned& nx) {
    const unsigned G = gridDim.x * gridDim.y * gridDim.z;
    unsigned sum, cnt, mine, sp = 0u;
    for (;;) {
        sum = 0u; cnt = 0u; mine = 0u;
#pragma unroll
        for (unsigned j = 0; j < 16; ++j) { const unsigned c = xb_ld(&bar[XB_XCNT(j)]); sum += c; cnt += (c > 0u) ? 1u : 0u; mine = (j == x) ? c : mine; }
        if (sum == G) break;
        __builtin_amdgcn_s_sleep(1);
        if ((++sp & 255u) == 0u) { if (xb_ld(&bar[XB_TMO])) break; if (sp > XB_SPIN_CAP) { atomicAdd(&bar[XB_TMO], 1u); break; } }
    }
    nloc = mine > 0u ? mine : 1u; nx = cnt > 0u ? cnt : 1u;
}
__device__ __forceinline__ void xcd_barrier(const XcdBarrier& b) {
    asm volatile("s_waitcnt vmcnt(0)" ::: "memory");
    __syncthreads();
    if (threadIdx.x == 0) {
        unsigned* bar = b.bar;
        __builtin_amdgcn_s_waitcnt(0);
        unsigned nloc = b.st[0], nx = b.st[1];
        if (nloc == 0u) { xcd_barrier_complete(bar, b.x, nloc, nx); b.st[0] = nloc; b.st[1] = nx; }
        const unsigned old = xb_add(&bar[XB_XSUB(b.x)], 1u);
        const unsigned gen = old / nloc;
        if (old + 1u == (gen + 1u) * nloc) {
            __builtin_amdgcn_fence(__ATOMIC_RELEASE, "agent");
            asm volatile("s_waitcnt vmcnt(0)" ::: "memory");
            const unsigned og = xb_add(&bar[XB_TOP], 1u);
            const unsigned tg = og / nx;
            if (og + 1u == (tg + 1u) * nx) xb_add(&bar[XB_TOPGEN], 1u);
            else XB_SPIN(xb_ld(&bar[XB_TOPGEN]) == tg, bar);
            __builtin_amdgcn_fence(__ATOMIC_ACQUIRE, "agent");
            xb_add(&bar[XB_XGEN(b.x)], 1u);
            asm volatile("s_waitcnt vmcnt(0)" ::: "memory");
        } else {
            XB_SPIN(xb_ld(&bar[XB_XGEN(b.x)]) == gen, bar);
            __builtin_amdgcn_fence(__ATOMIC_ACQUIRE, "agent");
            asm volatile("s_waitcnt vmcnt(0)" ::: "memory");
        }
    }
    __syncthreads();
}

#ifndef FLAT_BARRIER
#define FLAT_BARRIER 0
#endif
__device__ __forceinline__ void flat_barrier(unsigned* bar, unsigned& epoch) {
    asm volatile("s_waitcnt vmcnt(0)" ::: "memory");
    __syncthreads();
    ++epoch;
    if (threadIdx.x == 0) {
        __builtin_amdgcn_fence(__ATOMIC_RELEASE, "agent");
        asm volatile("s_waitcnt vmcnt(0)" ::: "memory");
        const unsigned target = epoch * gridDim.x;
        (void)xb_add(&bar[XB_TOP], 1u);
        unsigned sp = 0;
        while (xb_ld(&bar[XB_TOP]) < target) { __builtin_amdgcn_s_sleep(1);
            if ((++sp & 255u) == 0u) { if (xb_ld(&bar[XB_TMO])) break; if (sp > XB_SPIN_CAP) { atomicAdd(&bar[XB_TMO], 1u); break; } } }
        __builtin_amdgcn_fence(__ATOMIC_ACQUIRE, "agent");
        asm volatile("s_waitcnt vmcnt(0)" ::: "memory");
    }
    __syncthreads();
}
constexpr int NWAVES = 8;
constexpr int RING_BYTES = 131072, LDSCTL_OFF = 139264, MISC_OFF = LDSCTL_OFF + 320, LDS_BYTES = 147456;
constexpr int CW_BAR = 4096, CW_THIN = 8192;
constexpr int NPHASE = 9;
struct Args { const float* in[15]; float* out; unsigned char* ws; int ph_lo, ph_hi, flags, pad; };
struct Frame {
    LAS unsigned char* lds; volatile LAS unsigned* MISC; unsigned* ctl;
    int tid, lane, wave, vcu, G;
    const float *x, *meta, *g_mix, *w_in, *lam_vecs, *subln, *pool_w, *pool_scale, *w_o, *g_ffn, *router_w, *w_gate, *w_up, *w_down, *g_final;
    float* out;
    unsigned char* ws;
    __device__ __forceinline__ bf16* WIN() const { return (bf16*)(ws + WS_WIN); }
    __device__ __forceinline__ bf16* WO() const { return (bf16*)(ws + WS_WO); }
    __device__ __forceinline__ bf16* PW() const { return (bf16*)(ws + WS_PW); }
    __device__ __forceinline__ bf16* BT1() const { return (bf16*)(ws + WS_BT1); }
    __device__ __forceinline__ bf16* BT2() const { return (bf16*)(ws + WS_BT2); }
    __device__ __forceinline__ bf16* XN0() const { return (bf16*)(ws + WS_XN0); }
    __device__ __forceinline__ bf16* QKVU() const { return (bf16*)(ws + WS_QKVU); }
    __device__ __forceinline__ bf16* MIX() const { return (bf16*)(ws + WS_MIX); }
    __device__ __forceinline__ bf16* N2() const { return (bf16*)(ws + WS_N2); }
    __device__ __forceinline__ bf16* XG() const { return (bf16*)(ws + WS_XG); }
    __device__ __forceinline__ bf16* HID() const { return (bf16*)(ws + WS_HID); }
    __device__ __forceinline__ bf16* Y() const { return (bf16*)(ws + WS_Y); }
    __device__ __forceinline__ float* PART() const { return (float*)(ws + WS_PART); }
    __device__ __forceinline__ bf16* H1() const { return (bf16*)(ws + WS_H1); }
    __device__ __forceinline__ float* AFF() const { return (float*)(ws + WS_AFF); }
    __device__ __forceinline__ float* GATE() const { return (float*)(ws + WS_GATE); }
    __device__ __forceinline__ int* ROWIDX() const { return (int*)(ws + WS_ROWIDX); }
    __device__ __forceinline__ int* INV() const { return (int*)(ws + WS_INV); }
};

__device__ __forceinline__ void conv8x64(const float* src  , int ld, bf16* dst  , int lane) {
    float v[8];
#pragma unroll
    for (int j = 0; j < 8; ++j) v[j] = src[(size_t)j * ld + lane];
    u32x4 w; w.x = cvtpk(v[0], v[1]); w.y = cvtpk(v[2], v[3]); w.z = cvtpk(v[4], v[5]); w.w = cvtpk(v[6], v[7]);
    *(u32x4*)(dst + (size_t)lane * 8) = w;
}
constexpr int CT_BT1 = NE * 128 * 88, CT_BT2 = NE * 352 * 16, CT_EXPERT = CT_BT1 + CT_BT2;
__device__ __forceinline__ void conv_decode(Frame& F, int t, const float*& src, int& ld, bf16*& dst) {
    if (t < CT_BT1) { const int e = t / 11264, r = t - e * 11264, kb = r / 88, np = (r - kb * 88) * 64;
        const int up = (np >> 7) & 1, f0 = (np >> 8) * 128 + (np & 127);
        src = (up ? F.w_up : F.w_gate) + (size_t)e * D * FF + (size_t)(8 * kb) * FF + f0; ld = FF; dst = F.BT1() + (((size_t)(e * 22 + (np >> 8)) * (D / 8) + kb) * 256 + (np & 255)) * 8; }
    else { const int t2 = t - CT_BT1, e = t2 / 5632, r = t2 - e * 5632, kb = r >> 4, n0 = (r & 15) * 64;
        src = F.w_down + (size_t)e * FF * D + (size_t)(8 * kb) * D + n0; ld = D; dst = F.BT2() + (((size_t)(e * 4 + (n0 >> 8)) * (FF / 8) + kb) * 256 + (n0 & 255)) * 8; }
}
__device__ __forceinline__ void conv_expert_task(Frame& F, int t) { const float* src; int ld; bf16* dst; conv_decode(F, t, src, ld, dst); conv8x64(src, ld, dst, F.lane); }
__device__ __forceinline__ void p0b_expert_weights(Frame& F, int tstart) {
    const int NGW = F.G * NWAVES;
    for (int t = tstart; t < CT_EXPERT; t += NGW) conv_expert_task(F, t);
    __syncthreads();
}
__device__ __forceinline__ void p0_prologue(Frame& F) {
    const int gw = F.vcu * NWAVES + F.wave, NGW = F.G * NWAVES;
    constexpr int T_IN = 128 * 32, T_O = 128 * 16, T_P = 4 * 16 * 2;
    for (int t = gw; t < T_IN + T_O + T_P; t += NGW) {
        int r = t;
        if (r < T_IN) { const int kb = r >> 5, n0 = (r & 31) * 64; conv8x64(F.w_in + (size_t)(8 * kb) * INW + n0, INW, F.WIN() + (((size_t)(n0 >> 8) * (D / 8) + kb) * 256 + (n0 & 255)) * 8, F.lane); continue; }
        r -= T_IN;
        if (r < T_O) { const int kb = r >> 4, n0 = (r & 15) * 64; conv8x64(F.w_o + (size_t)(8 * kb) * D + n0, D, F.WO() + (((size_t)(n0 >> 8) * (D / 8) + kb) * 256 + (n0 & 255)) * 8, F.lane); continue; }
        r -= T_O;
        { const int g = r >> 5, kb = (r & 31) >> 1, n0 = (r & 1) * 64;
          conv8x64(F.pool_w + (size_t)g * 128 * 128 + (size_t)(8 * kb) * 128 + n0, 128, F.PW() + (size_t)g * 128 * 128 + ((size_t)kb * 128 + n0) * 8, F.lane); }
    }
    f32x4 gm[4];
#pragma unroll
    for (int j = 0; j < 4; ++j) gm[j] = ((const f32x4*)F.g_mix)[F.lane + 64 * j];
    for (int m = gw; m < MPAD; m += NGW) {
        unsigned long long* o8 = (unsigned long long*)(F.XN0() + (size_t)m * D) + F.lane;
        if (m < MTOK) {
            const f32x4* xr = (const f32x4*)h0_row(F.x, F.meta, m) + F.lane;
            f32x4 v[4]; float s = 0.f;
#pragma unroll
            for (int j = 0; j < 4; ++j) { v[j] = xr[64 * j]; s += (v[j].x * v[j].x + v[j].y * v[j].y) + (v[j].z * v[j].z + v[j].w * v[j].w); }
            const float r = 1.0f / sqrtf(wave_sum(s) * (1.f / D) + EPS);
#pragma unroll
            for (int j = 0; j < 4; ++j) { const f32x4 y = v[j] * r * gm[j]; o8[64 * j] = (unsigned long long)pk2(y.x, y.y) | ((unsigned long long)pk2(y.z, y.w) << 32); }
        } else {
#pragma unroll
            for (int j = 0; j < 4; ++j) o8[64 * j] = 0ull;
        }
    }
    { u32x4* z = (u32x4*)(F.QKVU() + (size_t)MTOK * INW); const int n = (MPAD - MTOK) * INW / 8;
      for (int i = F.vcu * 512 + F.tid; i < n; i += F.G * 512) z[i] = (u32x4){0u, 0u, 0u, 0u}; }
    { i32x4* inv = (i32x4*)F.INV(); const int n4 = MTOK * 16 / 4;
      for (int i = F.vcu * 512 + F.tid; i < n4; i += F.G * 512) inv[i] = (i32x4){-1, -1, -1, -1}; }
}

#define SBAR() __builtin_amdgcn_sched_barrier(0)
__device__ __forceinline__ int crow(int r, int hi) { return (r & 3) + 8 * (r >> 2) + 4 * hi; }
#ifndef ATT_SDEPTH
#define ATT_SDEPTH 1
#endif
constexpr float THR2 = 40.0f;
__device__ __forceinline__ int kswz(int row, int colB) { return row * 128 + (colB ^ (((row >> 1) & 7) << 4)); }
__device__ __forceinline__ int v_st(int k, int c) { const int kk = (k & ~0xC) | ((k & 4) << 1) | ((k & 8) >> 1); return ((kk >> 3) * 4 + (c >> 5)) * 512 + ((kk & 7) * 32 + (c & 31)) * 2; }
__device__ __forceinline__ int v_rd_base(int lane) { return ((lane & 3) << 3) | (((lane >> 2) & 3) << 6) | (((lane >> 4) & 1) << 5) | (((lane >> 5) & 1) << 11); }
constexpr int v_rd_off(int d0, int ks, int half) { return d0 * 512 + ks * 4096 + half * 256; }
template <int OFF> __device__ __forceinline__ s16x4 tr_read(int vb) {
    s16x4 r; asm volatile("ds_read_b64_tr_b16 %0, %1 offset:%2" : "=&v"(r) : "v"(vb), "i"(OFF) : "memory"); return r;
}
#define PV_READ8(F_, D0_) do { F_[0] = tr_read<v_rd_off(D0_, 0, 0)>(vb); F_[1] = tr_read<v_rd_off(D0_, 0, 1)>(vb); F_[2] = tr_read<v_rd_off(D0_, 1, 0)>(vb); F_[3] = tr_read<v_rd_off(D0_, 1, 1)>(vb); \
    F_[4] = tr_read<v_rd_off(D0_, 2, 0)>(vb); F_[5] = tr_read<v_rd_off(D0_, 2, 1)>(vb); F_[6] = tr_read<v_rd_off(D0_, 3, 0)>(vb); F_[7] = tr_read<v_rd_off(D0_, 3, 1)>(vb); } while (0)
#define PV_PK(Lx, Hx) (bf16x8){Lx[0], Lx[1], Lx[2], Lx[3], Hx[0], Hx[1], Hx[2], Hx[3]}
#define PV_MMA4(od, F_) do { od = __builtin_amdgcn_mfma_f32_32x32x16_bf16(pa0, PV_PK(F_[0], F_[1]), od, 0, 0, 0); od = __builtin_amdgcn_mfma_f32_32x32x16_bf16(pa1, PV_PK(F_[2], F_[3]), od, 0, 0, 0); \
    od = __builtin_amdgcn_mfma_f32_32x32x16_bf16(pa2, PV_PK(F_[4], F_[5]), od, 0, 0, 0); od = __builtin_amdgcn_mfma_f32_32x32x16_bf16(pa3, PV_PK(F_[6], F_[7]), od, 0, 0, 0); } while (0)
__device__ __forceinline__ void pv_pre(s16x4 (&fa)[8], s16x4 (&fb)[8], int vb) { PV_READ8(fa, 0); }
__device__ __forceinline__ void pv_main(f32x16* o, s16x4 (&fa)[8], s16x4 (&fb)[8], int vb, bf16x8 pa0, bf16x8 pa1, bf16x8 pa2, bf16x8 pa3) {
    PV_READ8(fb, 1); asm volatile("s_waitcnt lgkmcnt(8)" ::: "memory"); SBAR(); PV_MMA4(o[0], fa);
    PV_READ8(fa, 2); asm volatile("s_waitcnt lgkmcnt(8)" ::: "memory"); SBAR(); PV_MMA4(o[1], fb);
    PV_READ8(fb, 3); asm volatile("s_waitcnt lgkmcnt(8)" ::: "memory"); SBAR(); PV_MMA4(o[2], fa);
    asm volatile("s_waitcnt lgkmcnt(0)" ::: "memory"); SBAR(); PV_MMA4(o[3], fb);
}
__device__ __forceinline__ void pv_d0(f32x16* o, int vb, bf16x8 pa0, bf16x8 pa1, bf16x8 pa2, bf16x8 pa3) {
    s16x4 fa[8], fb[8]; pv_pre(fa, fb, vb); pv_main(o, fa, fb, vb, pa0, pa1, pa2, pa3);
}
template <int MODE> __device__ __forceinline__ void qkt(f32x16& p0, f32x16& p1, const LAS unsigned char* Kmap, const LAS bf16x8* qs, int r32, int hi, float sg  ) {
    if (MODE == 0) { p0 = f32x16{}; p1 = f32x16{}; }
    else { asm volatile("" : "+v"(sg));
#pragma unroll
        for (int r = 0; r < 16; ++r) { const float c = sg * (float)((r & 3) + 8 * (r >> 2)); p0[r] = c; p1[r] = c; } }
#pragma unroll
    for (int d0 = 0; d0 < 4; ++d0) { const int cb = (d0 * 16 + hi * 8) * 2;
        const bf16x8 b0 = *(const LAS bf16x8*)(Kmap + kswz(r32, cb));
        const bf16x8 b1 = *(const LAS bf16x8*)(Kmap + kswz(32 + r32, cb));
        const bf16x8 qf = qs[d0 * 64];
        p0 = __builtin_amdgcn_mfma_f32_32x32x16_bf16(b0, qf, p0, 0, 0, 0); p1 = __builtin_amdgcn_mfma_f32_32x32x16_bf16(b1, qf, p1, 0, 0, 0); }
}
__device__ __forceinline__ float max3f(float a, float b, float c) { float r; asm("v_max3_f32 %0, %1, %2, %3" : "=v"(r) : "v"(a), "v"(b), "v"(c)); return r; }
__device__ __forceinline__ void partialSM_lin(f32x16& p0, f32x16& p1, float& m_reg, float& mn, float& alpha, float a0, float a1) {
    float x0 = max3f(p0[0], p0[1], p0[2]), x1 = max3f(p1[0], p1[1], p1[2]);
#pragma unroll
    for (int r = 3; r < 15; r += 2) { x0 = max3f(x0, p0[r], p0[r + 1]); x1 = max3f(x1, p1[r], p1[r + 1]); }
    x0 = fmaxf(x0, p0[15]); x1 = fmaxf(x1, p1[15]);
    float pmax = fmaxf(x0 + a0, x1 + a1);
    { auto rr = __builtin_amdgcn_permlane32_swap(__float_as_uint(pmax), __float_as_uint(pmax), false, false);
      pmax = fmaxf(__uint_as_float(rr[0]), __uint_as_float(rr[1])); }
    if (__builtin_expect(__all(pmax - m_reg <= THR2), 1)) { mn = m_reg; alpha = 1.f; }
    else { mn = fmaxf(m_reg, pmax); alpha = __builtin_amdgcn_exp2f(m_reg - mn); m_reg = mn; }
    const float s0 = mn - a0, s1 = mn - a1;
#pragma unroll
    for (int r = 0; r < 16; ++r) { p0[r] -= s0; p1[r] -= s1; }
#pragma unroll
    for (int r = 0; r < 16; ++r) p0[r] = __builtin_amdgcn_exp2f(p0[r]);
}
__device__ __forceinline__ void partialSM(f32x16& p0, f32x16& p1, float& m_reg, float& mn, float& alpha, float dq, float nslope, int kbase  , bool masktile  ) {
#pragma unroll
    for (int r = 0; r < 16; ++r) { const float c = (float)((r & 3) + 8 * (r >> 2));
        p0[r] = fmaf(nslope, fabsf(dq - c), p0[r]); p1[r] = fmaf(nslope, fabsf(dq - (c + 32.f)), p1[r]); }
    if (masktile) {
#pragma unroll
        for (int r = 0; r < 16; ++r) { const int key = kbase + (r & 3) + 8 * (r >> 2); if (key >= L) p0[r] = -1e30f; if (key + 32 >= L) p1[r] = -1e30f; }
    }
    float pmax = p0[0];
#pragma unroll
    for (int r = 1; r < 16; ++r) pmax = fmaxf(pmax, p0[r]);
#pragma unroll
    for (int r = 0; r < 16; ++r) pmax = fmaxf(pmax, p1[r]);
    { auto rr = __builtin_amdgcn_permlane32_swap(__float_as_uint(pmax), __float_as_uint(pmax), false, false);
      pmax = fmaxf(__uint_as_float(rr[0]), __uint_as_float(rr[1])); }
    if (__builtin_expect(__all(pmax - m_reg <= THR2), 1)) { mn = m_reg; alpha = 1.f; }
    else { mn = fmaxf(m_reg, pmax); alpha = __builtin_amdgcn_exp2f(m_reg - mn); m_reg = mn; }
#pragma unroll
    for (int r = 0; r < 16; ++r) { p0[r] -= mn; p1[r] -= mn; }
#pragma unroll
    for (int r = 0; r < 16; ++r) p0[r] = __builtin_amdgcn_exp2f(p0[r]);
}
#define PK4(P, BASE, OUT) do { u32x4 w_ = {cvtpk(P[BASE + 0], P[BASE + 1]), cvtpk(P[BASE + 2], P[BASE + 3]), cvtpk(P[BASE + 4], P[BASE + 5]), cvtpk(P[BASE + 6], P[BASE + 7])}; \
    OUT = *reinterpret_cast<bf16x8*>(&w_); } while (0)
__device__ __forceinline__ void finish_p1(f32x16& q1, float ps, float alpha, float& l_reg, bf16x8& pa2, bf16x8& pa3) {
#pragma unroll
    for (int r = 0; r < 16; ++r) q1[r] = __builtin_amdgcn_exp2f(q1[r]);
#pragma unroll
    for (int r = 0; r < 16; ++r) ps += q1[r];
    { auto rr = __builtin_amdgcn_permlane32_swap(__float_as_uint(ps), __float_as_uint(ps), false, false);
      ps = __uint_as_float(rr[0]) + __uint_as_float(rr[1]); }
    l_reg = l_reg * alpha + ps;
    PK4(q1, 0, pa2); PK4(q1, 8, pa3);
}
__device__ __forceinline__ void pack_p0(f32x16& c0, float& ps, bf16x8& pa0, bf16x8& pa1) {
    float t = 0.f;
#pragma unroll
    for (int r = 0; r < 16; ++r) t += c0[r];
    ps = t;
    PK4(c0, 0, pa0); PK4(c0, 8, pa1);
}
#define MF32(A_, B_, C_) __builtin_amdgcn_mfma_f32_32x32x16_bf16(A_, B_, C_, 0, 0, 0)
#define LGKM(N) asm volatile("s_waitcnt lgkmcnt(" #N ")" ::: "memory")
__device__ __forceinline__ void step_lin(f32x16* o, const LAS unsigned char* Kmap, const LAS bf16x8* qs, int vb, int r32, int hi, float sg, float a0, float a1,
        f32x16& q1, float psP, float alP, float& l_reg, bf16x8 paP0, bf16x8 paP1,
        f32x16& c1, float& psC, float& alC, bf16x8& paC0, bf16x8& paC1, float& m_reg) {
    s16x4 fa[8], fb[8]; bf16x8 pa2, pa3, kA0, kA1, qA, kB0, kB1, qB; f32x16 c0, ci0, ci1;
    { const float b0 = a0 - m_reg, b1 = a1 - m_reg;
      asm volatile("" : "+v"(sg));
#pragma unroll
      for (int r = 0; r < 16; ++r) { const float cr = (float)((r & 3) + 8 * (r >> 2)); ci0[r] = fmaf(sg, cr, b0); ci1[r] = fmaf(sg, cr, b1); } }
#define KQ_READ(d0, k0_, k1_, q_) do { const int cb_ = ((d0) * 16 + hi * 8) * 2; k0_ = *(const LAS bf16x8*)(Kmap + kswz(r32, cb_)); k1_ = *(const LAS bf16x8*)(Kmap + kswz(32 + r32, cb_)); q_ = qs[(d0) * 64]; } while (0)
#define EX(r) q1[r] = __builtin_amdgcn_exp2f(q1[r])
#define AD(r) ps += q1[r]
    float ps = psP;
    KQ_READ(0, kA0, kA1, qA);
    SBAR();
    c0 = MF32(kA0, qA, ci0); KQ_READ(1, kB0, kB1, qB); EX(0); EX(1); EX(2); SBAR();
    c1 = MF32(kA1, qA, ci1); EX(3); EX(4); EX(5); AD(0); AD(1); AD(2); SBAR();
    c0 = MF32(kB0, qB, c0); KQ_READ(2, kA0, kA1, qA); EX(6); EX(7); EX(8); AD(3); AD(4); AD(5); SBAR();
    c1 = MF32(kB1, qB, c1); EX(9); EX(10); AD(6); AD(7); PK4(q1, 0, pa2); SBAR();
    c0 = MF32(kA0, qA, c0); KQ_READ(3, kB0, kB1, qB); EX(11); EX(12); EX(13); AD(8); AD(9); AD(10); SBAR();
    c1 = MF32(kA1, qA, c1); EX(14); EX(15); AD(11); AD(12); AD(13); PK4(q1, 8, pa3); SBAR();
    c0 = MF32(kB0, qB, c0); PV_READ8(fa, 0); AD(14); AD(15);
    { auto rr = __builtin_amdgcn_permlane32_swap(__float_as_uint(ps), __float_as_uint(ps), false, false);
      ps = __uint_as_float(rr[0]) + __uint_as_float(rr[1]); }
    l_reg = l_reg * alP + ps; asm volatile("" : "+v"(l_reg)); SBAR();
    c1 = MF32(kB1, qB, c1); PV_READ8(fb, 1); SBAR();
#undef KQ_READ
#undef EX
#undef AD
#define RD2(F_, D0_, K_) do { F_[2 * (K_)] = tr_read<v_rd_off(D0_, K_, 0)>(vb); F_[2 * (K_) + 1] = tr_read<v_rd_off(D0_, K_, 1)>(vb); } while (0)
#define PVM(d, k, F_, PA_) o[d] = MF32(PA_, PV_PK(F_[2 * (k)], F_[2 * (k) + 1]), o[d])
    float x0, x1, t = 0.f;
#define MX_HEAD(X, C) asm("v_max3_f32 %0, %1, %2, %3\n\tv_max3_f32 %0, %0, %4, %5\n\tv_max3_f32 %0, %0, %6, %7\n\tv_max3_f32 %0, %0, %8, %9" : "=&v"(X) : "v"(C[0]), "v"(C[1]), "v"(C[2]), "v"(C[3]), "v"(C[4]), "v"(C[5]), "v"(C[6]), "v"(C[7]), "v"(C[8]))
#define MX_TAIL(X, C) asm("v_max3_f32 %0, %0, %1, %2\n\tv_max3_f32 %0, %0, %3, %4\n\tv_max3_f32 %0, %0, %5, %6\n\tv_max_f32 %0, %0, %7" : "+v"(X) : "v"(C[9]), "v"(C[10]), "v"(C[11]), "v"(C[12]), "v"(C[13]), "v"(C[14]), "v"(C[15]))
    LGKM(14); SBAR(); PVM(0, 0, fa, paP0); RD2(fa, 2, 0); MX_HEAD(x0, c0); SBAR();
    LGKM(14); SBAR(); PVM(0, 1, fa, paP1); RD2(fa, 2, 1); MX_TAIL(x0, c0); SBAR();
    LGKM(14); SBAR(); PVM(0, 2, fa, pa2); RD2(fa, 2, 2); MX_HEAD(x1, c1); SBAR();
    LGKM(14); SBAR(); PVM(0, 3, fa, pa3); RD2(fa, 2, 3); MX_TAIL(x1, c1); SBAR();
#undef MX_HEAD
#undef MX_TAIL
    LGKM(14); SBAR(); PVM(1, 0, fb, paP0); RD2(fb, 3, 0);
    { float pmax = fmaxf(x0, x1);
      { auto rr = __builtin_amdgcn_permlane32_swap(__float_as_uint(pmax), __float_as_uint(pmax), false, false);
        pmax = fmaxf(__uint_as_float(rr[0]), __uint_as_float(rr[1])); }
      alC = 1.f;
      if (__builtin_expect(!__all(pmax <= THR2), 0)) {
          const float dl = fmaxf(pmax, 0.f);
          alC = __builtin_amdgcn_exp2f(-dl); m_reg += dl;
#pragma unroll
          for (int r = 0; r < 16; ++r) { c0[r] -= dl; c1[r] -= dl; }
          asm volatile("" : "+v"(c0), "+v"(c1));
      } }
    SBAR();
#define SE(i) do { c0[2 * (i)] = __builtin_amdgcn_exp2f(c0[2 * (i)]); c0[2 * (i) + 1] = __builtin_amdgcn_exp2f(c0[2 * (i) + 1]); } while (0)
#define SA(i) do { t += c0[2 * (i)]; t += c0[2 * (i) + 1]; } while (0)
    LGKM(14); SBAR(); PVM(1, 1, fb, paP1); RD2(fb, 3, 1); SE(0); SBAR();
    LGKM(14); SBAR(); PVM(1, 2, fb, pa2); RD2(fb, 3, 2); SE(1); SBAR();
    LGKM(14); SBAR(); PVM(1, 3, fb, pa3); RD2(fb, 3, 3); SE(2); SA(0); SBAR();
    LGKM(14); SBAR(); PVM(2, 0, fa, paP0); SE(3); SA(1); SBAR();
    LGKM(12); SBAR(); PVM(2, 1, fa, paP1); SE(4); SA(2); SBAR();
    LGKM(10); SBAR(); PVM(2, 2, fa, pa2); SE(5); SA(3); SBAR();
    LGKM(8); SBAR(); PVM(2, 3, fa, pa3); SE(6); SA(4); SBAR();
    LGKM(6); SBAR(); PVM(3, 0, fb, paP0); SE(7); SA(5); SBAR();
    LGKM(4); SBAR(); PVM(3, 1, fb, paP1); SA(6); SA(7); PK4(c0, 0, paC0); SBAR();
    LGKM(2); SBAR(); PVM(3, 2, fb, pa2); PK4(c0, 8, paC1); SBAR();
    LGKM(0); SBAR(); PVM(3, 3, fb, pa3); psC = t; asm volatile("" :: "v"(psC), "v"(paC0), "v"(paC1), "v"(alC)); SBAR();
#undef SE
#undef SA
#undef RD2
#undef PVM
}
constexpr int ATT_V = 0  , ATT_K = 49152  , ATT_WS = 98304, ATT_Q = 102400  , ATT_CB = 0;
constexpr int NT_ATT = 66;
template <int ABL> __device__ __forceinline__ void attn_unit(Frame& F, int b, int h, int t0, float lam, int j0, int NT, int part, int& ctask) {
    const int tid = F.tid, lane = F.lane, wid = F.wave, r32 = lane & 31, hi = lane >> 5, map = wid >> 2, wq = wid & 3;
    LAS unsigned char* lds = F.lds;
    LAS float* wsf = (LAS float*)(lds + ATT_WS) + wid * 64; LAS float* li_l = wsf; LAS float* al_l = wsf + 32;
    const float slope2 = exp2f(-2.0f * (float)(h + 1)) * LOG2E;
    const float nslope = -slope2;
    const int trow = t0 + 32 * wq + r32;
    const int trow_ld = trow < L ? trow : L - 1;
    LAS bf16x8* qr = (LAS bf16x8*)(lds + ATT_Q) + wid * 256 + lane;
    const char* Kg = (const char*)(F.QKVU() + ((size_t)b * L + (size_t)j0 * 64) * INW + COL_K1 + h * DQK);
    const char* Vg = (const char*)(F.QKVU() + ((size_t)b * L + (size_t)j0 * 64) * INW + COL_V + h * DV);
    unsigned dk, dv0, dv1;
    { const int row = 8 * wid + (lane >> 3), c = (lane & 7) ^ ((row >> 1) & 7); dk = (unsigned)(row * INW + c * 8) * 2u; }
    { const int kk = 8 * wid + ((lane & 31) >> 2), k = (kk & ~0xC) | ((kk & 4) << 1) | ((kk & 8) >> 1), cb = lane >> 5, c8 = (lane & 3) * 8;
      dv0 = (unsigned)(k * INW + cb * 32 + c8) * 2u; dv1 = (unsigned)(k * INW + (2 + cb) * 32 + c8) * 2u; }
    const unsigned wl = (unsigned)wid * 1024u;
    constexpr size_t TSTR = (size_t)64 * INW * 2;
#define DMA16(gp, off) if (!(ABL & 8)) __builtin_amdgcn_global_load_lds((const unsigned*)(gp), (LAS unsigned*)(lds + (off)), 16, 0, 0)
#define DMA_K(t, slot) do { const char* g_ = Kg + (size_t)(t) * TSTR; DMA16(g_ + dk, ATT_K + (slot) + wl); DMA16(g_ + 512 + dk, ATT_K + (slot) + 8192 + wl); } while (0)
#define DMA_V(t, slot) do { const char* g_ = Vg + (size_t)(t) * TSTR; DMA16(g_ + dv0, ATT_V + (slot) + 2 * wl); DMA16(g_ + dv1, ATT_V + (slot) + 2 * wl + 1024); } while (0)
    const int vb0 = (int)(unsigned)(uintptr_t)(lds + ATT_V) + v_rd_base(lane);
    const LAS unsigned char* Kmap0 = lds + ATT_K + map * 8192;
    const float qposf = (float)(trow - 64 * j0 - 4 * hi);
    const int kb0 = 64 * j0 + 4 * hi;
    float m_reg = -1e30f, l_reg = 0.f; f32x16 o[4] = {};
#define RESC(a) do { if (__any((a) < 1.f)) { if (hi == 0) al_l[r32] = (a); asm volatile("s_waitcnt lgkmcnt(0)" ::: "memory"); \
    _Pragma("unroll") for (int d = 0; d < 4; ++d) _Pragma("unroll") for (int r = 0; r < 16; ++r) o[d][r] *= al_l[crow(r, hi)]; } } while (0)
#define DQ(j) (qposf - (float)(64 * (j)))
#define KB(j) (kb0 + 64 * (j))
    const int r0w = t0 + 32 * wq - 64 * j0;
#define TMODE(j) ((64 * (j0 + (j)) + 64 > L) ? 0 : (r0w >= 64 * (j) + 64) ? 1 : (r0w + 31 < 64 * (j)) ? 2 : 0)
#define STEP_LIN(X, Y, j, sg_) do { const float dq_ = DQ(j); step_lin(o, Kmap0 + s0, qr, vb0 + s2, r32, hi, sg_, -(sg_) * dq_, -(sg_) * (dq_ - 32.f), \
        p1##X, ps##X, al##X, l_reg, pa##X##0, pa##X##1, p1##Y, ps##Y, al##Y, pa##Y##0, pa##Y##1, m_reg); } while (0)
#define STEP_GEN(X, Y, j, sg_) do { f32x16 c0_; float mn_; bf16x8 pa2_, pa3_; SBAR(); qkt<0>(c0_, p1##Y, Kmap0 + s0, qr, r32, hi, sg_); finish_p1(p1##X, ps##X, al##X, l_reg, pa2_, pa3_); \
        pv_d0(o, vb0 + s2, pa##X##0, pa##X##1, pa2_, pa3_); partialSM(c0_, p1##Y, m_reg, mn_, al##Y, DQ(j), nslope, KB(j), 64 * (j0 + (j)) + 64 > L); pack_p0(c0_, ps##Y, pa##Y##0, pa##Y##1); } while (0)
#define STEP_M(M, X, Y, j, sg_) do { if (M == 1) STEP_LIN(X, Y, j, sg_); else STEP_GEN(X, Y, j, sg_); } while (0)
#define WAITBAR(N) asm volatile("s_waitcnt vmcnt(" #N ") lgkmcnt(0)\n\ts_barrier" ::: "memory")
#define ENDW(i) do { if ((i) + 2 < NT) WAITBAR(4); else if ((i) + 1 < NT) WAITBAR(2); else WAITBAR(0); } while (0)
#define ROT() do { const int t_ = s0; s0 = s1; s1 = s2; s2 = t_; } while (0)
    f32x16 p1A, p1B; float psA, psB, alA, alB; bf16x8 paA0, paA1, paB0, paB1;
    int s0 = 0, s1 = 16384, s2 = 32768;
    DMA_K(0, s0); DMA_V(0, s0); DMA_K(1, s1);
    { const bf16* Qw = F.QKVU() + ((size_t)b * L + trow_ld) * INW + map * 256 + h * DQK + hi * 8;
#pragma unroll
      for (int d0 = 0; d0 < 4; ++d0) qr[d0 * 64] = *(const bf16x8*)(Qw + d0 * 16); }
    WAITBAR(0);
    DMA_K(2, s2); DMA_V(1, s1);
    { const int md_ = TMODE(0); const float sg_ = md_ == 1 ? slope2 : nslope; f32x16 c0_; float mn_; const float dq_ = DQ(0);
      if (md_ != 0) { qkt<1>(c0_, p1A, Kmap0 + s0, qr, r32, hi, sg_); partialSM_lin(c0_, p1A, m_reg, mn_, alA, -sg_ * dq_, -sg_ * (dq_ - 32.f)); }
      else { qkt<0>(c0_, p1A, Kmap0 + s0, qr, r32, hi, sg_); partialSM(c0_, p1A, m_reg, mn_, alA, dq_, nslope, KB(0), 64 * j0 + 64 > L); }
      pack_p0(c0_, psA, paA0, paA1); }
    ENDW(0); ROT();
    const int adiag = (t0 + 32 * wq) >> 6;
#define SG(j) ((j0 + (j)) < adiag ? slope2 : nslope)
    float cv0 = 0.f, cv1 = 0.f, cv2 = 0.f, cv3 = 0.f, cv4 = 0.f, cv5 = 0.f, cv6 = 0.f, cv7 = 0.f; bf16* cdst;
#define CONV_LOAD() do { cdst = nullptr; if (ctask < CT_EXPERT) { const float* cs_; int cl_; conv_decode(F, ctask, cs_, cl_, cdst); \
        cv0 = cs_[lane]; cv1 = (cs_ + (size_t)cl_)[lane]; cv2 = (cs_ + (size_t)2 * cl_)[lane]; cv3 = (cs_ + (size_t)3 * cl_)[lane]; \
        cv4 = (cs_ + (size_t)4 * cl_)[lane]; cv5 = (cs_ + (size_t)5 * cl_)[lane]; cv6 = (cs_ + (size_t)6 * cl_)[lane]; cv7 = (cs_ + (size_t)7 * cl_)[lane]; } \
        ctask += 2048; } while (0)
#define CONV_STORE() do { if (cdst) { u32x4 w_; w_.x = cvtpk(cv0, cv1); w_.y = cvtpk(cv2, cv3); w_.z = cvtpk(cv4, cv5); w_.w = cvtpk(cv6, cv7); *(u32x4*)(cdst + (size_t)lane * 8) = w_; cdst = nullptr; } } while (0)
#define ENDWC(i) do { if (cdst) WAITBAR(12); else ENDW(i); } while (0)
#define PAIR_M(M, j) do { \
        if ((j) + 2 < NT) DMA_K((j) + 2, s2); DMA_V((j) + 1, s1); \
        STEP_M(M, A, B, (j), SG(j)); RESC(alB); SBAR(); CONV_STORE(); SBAR(); CONV_LOAD(); SBAR(); ENDWC(j); ROT(); \
        if ((j) + 3 < NT) DMA_K((j) + 3, s2); if ((j) + 2 < NT) DMA_V((j) + 2, s1); \
        STEP_M(M, B, A, (j) + 1, SG((j) + 1)); RESC(alA); SBAR(); CONV_STORE(); SBAR(); CONV_LOAD(); SBAR(); ENDWC((j) + 1); ROT(); } while (0)
    cdst = nullptr;
    {
        const bool allgen = part >= 0;
        const int jd = allgen ? 1 : 2 * ((adiag + 1) >> 1) - 1;
        int j = 1;
#pragma unroll 1
        for (; j + 1 < NT && j < jd; j += 2) PAIR_M(1, j);
        if (j + 1 < NT) { PAIR_M(0, j); j += 2; }
#pragma unroll 1
        for (; !allgen && j + 1 < NT - 2; j += 2) PAIR_M(1, j);
#pragma unroll 1
        for (; j + 1 < NT; j += 2) PAIR_M(0, j);
    }
    CONV_STORE();
    STEP_M(0, A, B, NT - 1, nslope);
    RESC(alB);
    WAITBAR(0); ROT();
    { bf16x8 pa2_, pa3_; finish_p1(p1B, psB, alB, l_reg, pa2_, pa3_); SBAR();
      pv_d0(o, vb0 + s2, paB0, paB1, pa2_, pa3_); }
    if (part >= 0) {
        __syncthreads();
        LAS float* CBp = (LAS float*)(lds + ATT_CB);
        if (wq == 0) {
#pragma unroll
            for (int r = 0; r < 8; ++r)
#pragma unroll
                for (int d0 = 0; d0 < 4; ++d0) CBp[(16 * map + crow(r, hi)) * 128 + d0 * 32 + r32] = o[d0][r];
            if (hi == 0 && r32 < 16) { CBp[4096 + (16 * map + r32) * 2] = m_reg; CBp[4096 + (16 * map + r32) * 2 + 1] = l_reg; }
        }
        asm volatile("s_waitcnt lgkmcnt(0)" ::: "memory");
        __syncthreads();
        { float* PB = F.PART() + (size_t)((b * NH + h) * 16 + part) * 2 * 16 * 132;
          const int mr = tid >> 4, c8 = (tid & 15) * 8;
          const f32x4 v0 = *(const LAS f32x4*)(CBp + mr * 128 + c8), v1 = *(const LAS f32x4*)(CBp + mr * 128 + c8 + 4);
          *(f32x4*)(PB + mr * 132 + c8) = v0; *(f32x4*)(PB + mr * 132 + c8 + 4) = v1;
          if ((tid & 15) == 0) { PB[mr * 132 + 128] = CBp[4096 + mr * 2]; PB[mr * 132 + 129] = CBp[4096 + mr * 2 + 1]; } }
        asm volatile("s_waitcnt vmcnt(0)" ::: "memory");
        __syncthreads();
        LAS unsigned* flag = (LAS unsigned*)(lds + ATT_WS + 2048);
        if (tid == 0) {
            __builtin_amdgcn_fence(__ATOMIC_RELEASE, "agent");
            asm volatile("s_waitcnt vmcnt(0)" ::: "memory");
            const unsigned old = __hip_atomic_fetch_add(F.ctl + CW_THIN + 64 * (b * NH + h), 1u, __ATOMIC_RELAXED, __HIP_MEMORY_SCOPE_AGENT);
            flag[0] = (old == 15u) ? 1u : 0u;
            if (old == 15u) { __builtin_amdgcn_fence(__ATOMIC_ACQUIRE, "agent"); asm volatile("s_waitcnt vmcnt(0)" ::: "memory"); }
        }
        asm volatile("s_waitcnt lgkmcnt(0)" ::: "memory");
        __syncthreads();
        if (flag[0] != 0u) {
            const int row = tid >> 5, c4 = (tid & 31) * 4;
            const float* P0 = F.PART() + (size_t)((b * NH + h) * 16) * 2 * 16 * 132 + row * 132;
            f32x4 On[2];
#pragma unroll
            for (int mp = 0; mp < 2; ++mp) {
                float mm = -1e30f;
#pragma unroll 1
                for (int p = 0; p < 16; ++p) mm = fmaxf(mm, P0[(size_t)(p * 2 + mp) * 16 * 132 + 128]);
                f32x4 acc = {0.f, 0.f, 0.f, 0.f}; float ll = 0.f;
#pragma unroll 2
                for (int p = 0; p < 16; ++p) { const float* pp = P0 + (size_t)(p * 2 + mp) * 16 * 132; const float w = exp2f(pp[128] - mm);
                    acc += w * *(const f32x4*)(pp + c4); ll += w * pp[129]; }
                On[mp] = acc * (1.0f / ll);
            }
            const f32x4 dv = On[0] - lam * On[1];
            float ss = (dv[0] * dv[0] + dv[1] * dv[1]) + (dv[2] * dv[2] + dv[3] * dv[3]);
#pragma unroll
            for (int off = 1; off < 32; off <<= 1) ss += __shfl_xor(ss, off);
            const float rs = 0.8f / sqrtf(ss * (1.f / 128.f) + EPS);
            const f32x4 gn = *(const f32x4*)(F.subln + c4);
            u32x2 w; w.x = cvtpk(dv[0] * rs * gn[0], dv[1] * rs * gn[1]); w.y = cvtpk(dv[2] * rs * gn[2], dv[3] * rs * gn[3]);
            *(u32x2*)(F.MIX() + ((size_t)b * L + t0 + row) * D + h * DV + c4) = w;
        }
        __syncthreads();
    } else {
    if (hi == 0) li_l[r32] = l_reg; asm volatile("s_waitcnt lgkmcnt(0)" ::: "memory");
    float rli[16];
#pragma unroll
    for (int r = 0; r < 16; ++r) rli[r] = __builtin_amdgcn_rcpf(li_l[crow(r, hi)]);
    __syncthreads();
    LAS float* CB = (LAS float*)(lds + ATT_CB);
    if (map == 1) {
#pragma unroll
        for (int r = 0; r < 16; ++r)
#pragma unroll
            for (int d0 = 0; d0 < 4; ++d0) CB[(32 * wq + crow(r, hi)) * 128 + d0 * 32 + r32] = lam * o[d0][r] * rli[r];
    }
    __syncthreads();
    if (map == 0) {
        float gain[4];
#pragma unroll
        for (int d0 = 0; d0 < 4; ++d0) gain[d0] = F.subln[d0 * 32 + r32] * 0.8f;
#pragma unroll
        for (int r = 0; r < 16; ++r) {
            float dv[4]; float ss = 0.f;
#pragma unroll
            for (int d0 = 0; d0 < 4; ++d0) { dv[d0] = o[d0][r] * rli[r] - CB[(32 * wq + crow(r, hi)) * 128 + d0 * 32 + r32]; ss += dv[d0] * dv[d0]; }
#pragma unroll
            for (int off = 1; off < 32; off <<= 1) ss += __shfl_xor(ss, off);
            const float rs = 1.0f / sqrtf(ss * (1.f / 128.f) + EPS);
            const int tr = t0 + 32 * wq + crow(r, hi);
            if (tr < L) { bf16* op = F.MIX() + ((size_t)b * L + tr) * D + h * DV + r32;
#pragma unroll
                for (int d0 = 0; d0 < 4; ++d0) op[d0 * 32] = (bf16)f2bf(dv[d0] * rs * gain[d0]); }
        }
    }
    __syncthreads();
    }
#undef DMA16
#undef DMA_K
#undef DMA_V
#undef WAITBAR
#undef ENDW
#undef ROT
#undef RESC
#undef DQ
#undef KB
#undef TMODE
#undef STEP_LIN
#undef STEP_GEN
#undef STEP_M
#undef SG
#undef PAIR_M
#undef CONV_LOAD
#undef CONV_STORE
#undef ENDWC
}
__device__ __forceinline__ float lam_value(const float* lv, int lane) {
    const float s1 = wave_sum(lv[lane] * lv[64 + lane]), s2 = wave_sum(lv[128 + lane] * lv[192 + lane]);
    return expf(s1) - expf(s2) + 0.2f;
}
constexpr int POOL_PITCH = 1056, POOL_HALF_BYTES = 32 * POOL_PITCH;
template <int GI> __device__ __forceinline__ void pool_group(Frame& F, const LAS unsigned char* ub, int t, int m, int tl, int q) {
    constexpr int w2 = 1 << GI, W = 2 * w2;
    int lo = t - w2; if (lo < 0) lo = 0; int hiT = t + w2; if (hiT > L) hiT = L;
    const float inv = 1.0f / (float)(hiT - lo);
    bf16x8 pf[4];
#pragma unroll
    for (int ks = 0; ks < 4; ++ks) {
        const LAS unsigned char* up = ub + (tl + 8 - w2) * POOL_PITCH + (GI * 128 + ks * 32 + 8 * q) * 2;
        float s[8];
#pragma unroll
        for (int c = 0; c < 8; ++c) s[c] = 0.f;
#pragma unroll
        for (int i = 0; i < W; ++i) { const int tt = t - w2 + i; const float f = (tt >= 0 && tt < L) ? 1.f : 0.f; const u32x4 v = *(const LAS u32x4*)(up + i * POOL_PITCH);
            s[0] += f * __uint_as_float(v.x << 16); s[1] += f * __uint_as_float(v.x & 0xffff0000u); s[2] += f * __uint_as_float(v.y << 16); s[3] += f * __uint_as_float(v.y & 0xffff0000u);
            s[4] += f * __uint_as_float(v.z << 16); s[5] += f * __uint_as_float(v.z & 0xffff0000u); s[6] += f * __uint_as_float(v.w << 16); s[7] += f * __uint_as_float(v.w & 0xffff0000u); }
        const u32x4 vc = *(const LAS u32x4*)(up + w2 * POOL_PITCH);
        u32x4 w;
        w.x = cvtpk(s[0] * inv - __uint_as_float(vc.x << 16), s[1] * inv - __uint_as_float(vc.x & 0xffff0000u));
        w.y = cvtpk(s[2] * inv - __uint_as_float(vc.y << 16), s[3] * inv - __uint_as_float(vc.y & 0xffff0000u));
        w.z = cvtpk(s[4] * inv - __uint_as_float(vc.z << 16), s[5] * inv - __uint_as_float(vc.z & 0xffff0000u));
        w.w = cvtpk(s[6] * inv - __uint_as_float(vc.w << 16), s[7] * inv - __uint_as_float(vc.w & 0xffff0000u));
        pf[ks] = *reinterpret_cast<bf16x8*>(&w);
        asm volatile("" ::: "memory");
    }
    const bf16* Wp = F.PW() + (size_t)GI * 128 * 128 + ((size_t)q * 128 + tl) * 8;
    bf16* op = F.MIX() + (size_t)m * D + 512 + GI * 128 + 4 * q;
    const float* psc = F.pool_scale + GI * 128 + 4 * q;
#pragma unroll 2
    for (int nt = 0; nt < 8; ++nt) {
        f32x4 acc = {0.f, 0.f, 0.f, 0.f};
#pragma unroll
        for (int ks = 0; ks < 4; ++ks) { const bf16x8 wf = *(const bf16x8*)(Wp + ((size_t)ks * 4 * 128 + nt * 16) * 8);
            acc = __builtin_amdgcn_mfma_f32_16x16x32_bf16(wf, pf[ks], acc, 0, 0, 0); }
        const f32x4 sc = *(const f32x4*)(psc + nt * 16);
        u32x2 w; w.x = cvtpk(acc[0] * sc[0], acc[1] * sc[1]); w.y = cvtpk(acc[2] * sc[2], acc[3] * sc[3]);
        *(u32x2*)(op + nt * 16) = w;
    }
}
__device__ __forceinline__ void p2_pool(Frame& F) {
    const int half = F.wave >> 2, gi = F.wave & 3, lane = F.lane, tl = lane & 15, q = lane >> 4, ht = F.tid & 255;
    LAS unsigned char* ub = F.lds + half * POOL_HALF_BYTES;
    constexpr int NGR = MTOK / 16;
    for (int gb = F.vcu * 2; gb < NGR; gb += F.G * 2) {
        const int g16 = gb + half; const bool valid = g16 < NGR;
        const int b = valid ? g16 / 257 : 0, t0 = valid ? (g16 - b * 257) * 16 : 0;
        const bf16* U = F.QKVU() + (size_t)b * L * INW + COL_U;
        if (valid) {
#pragma unroll
            for (int k = 0; k < 8; ++k) { const int idx = ht + 256 * k, row = idx >> 6, ch = idx & 63; int tt = t0 - 8 + row; tt = tt < 0 ? 0 : (tt >= L ? L - 1 : tt);
                const u32x4 v = *(const u32x4*)(U + (size_t)tt * INW + ch * 8); *(LAS u32x4*)(ub + row * POOL_PITCH + ch * 16) = v; }
        }
        __syncthreads();
        if (valid) { const int t = t0 + tl, m = b * L + t;
            switch (gi) { case 0: pool_group<0>(F, ub, t, m, tl, q); break; case 1: pool_group<1>(F, ub, t, m, tl, q); break;
                          case 2: pool_group<2>(F, ub, t, m, tl, q); break; default: pool_group<3>(F, ub, t, m, tl, q); break; } }
        __syncthreads();
    }
}
template <int ABL> __device__ __forceinline__ int p2_attention(Frame& F, int ctask0) {
    const float lam = lam_value(F.lam_vecs, F.lane);
    const int v = F.vcu, x = v >> 5, q = v & 31;
    int ctask = ctask0;
#pragma unroll 1
    for (int i = 0; i < 3; ++i) {
        const int bh = (i < 2) ? 2 * x + i : (v >> 4), t0 = (i < 2) ? q * 128 : 32 * 128;
        const int part = (i < 2) ? -1 : (v & 15);
        const int j0 = (i < 2) ? 0 : 4 * part, NT = (i < 2) ? NT_ATT : (part == 15 ? 6 : 4);
        attn_unit<ABL>(F, bh >> 2, bh & 3, t0, lam, j0, NT, part, ctask);
    }
    return ctask;
}

#define LDH1(dst, m_) do { const unsigned long long* xr_ = (const unsigned long long*)(F.H1() + (size_t)(m_) * D) + lane; \
        _Pragma("unroll") for (int j = 0; j < 4; ++j) { const unsigned long long w_ = xr_[64 * j]; const unsigned lo_ = (unsigned)w_, hi_ = (unsigned)(w_ >> 32); \
            dst[j].x = __uint_as_float(lo_ << 16); dst[j].y = __uint_as_float(lo_ & 0xffff0000u); dst[j].z = __uint_as_float(hi_ << 16); dst[j].w = __uint_as_float(hi_ & 0xffff0000u); } } while (0)
__device__ __forceinline__ void p4_norm_router(Frame& F) {
    LAS unsigned short* wp = (LAS unsigned short*)F.lds;
    LAS float* gl = (LAS float*)(F.lds + 98304);
    for (int idx = F.tid; idx < 16384; idx += 512) { const int d = idx >> 4, e = idx & 15; const float w = F.router_w[idx] * F.g_ffn[d];
        const unsigned h = f2bf(w); const float r1 = w - __uint_as_float(h << 16); const unsigned md = f2bf(r1); const float r2 = r1 - __uint_as_float(md << 16); const unsigned lw = f2bf(r2);
        const int o = ((d >> 5) * 16 + e) * 32 + (d & 31); wp[o] = (unsigned short)h; wp[16384 + o] = (unsigned short)md; wp[32768 + o] = (unsigned short)lw; }
    for (int d = F.tid; d < 1024; d += 512) gl[d] = F.g_ffn[d];
    __syncthreads();
    const int lane = F.lane, fr = lane & 15, fq = lane >> 4;
    const int blk = F.wave * 256 + F.vcu;
    if (blk < MTOK / 16) {
        const int row = blk * 16 + fr;
        const bf16x8* xp = (const bf16x8*)(F.H1() + (size_t)row * D + 8 * fq);
        f32x4 acc = {0.f, 0.f, 0.f, 0.f}; float ss = 0.f;
        const LAS bf16x8* wf = (const LAS bf16x8*)(wp + fr * 32 + 8 * fq);
        bf16x8 xa[8], xb[8];
#pragma unroll
        for (int s = 0; s < 8; ++s) xa[s] = xp[s * 4];
#define P4_CHUNK(X, c) _Pragma("unroll") for (int s = 0; s < 8; ++s) { const int sg_ = (c) * 8 + s; \
            acc = __builtin_amdgcn_mfma_f32_16x16x32_bf16(wf[sg_ * 64], X[s], acc, 0, 0, 0); \
            acc = __builtin_amdgcn_mfma_f32_16x16x32_bf16(wf[2048 + sg_ * 64], X[s], acc, 0, 0, 0); \
            acc = __builtin_amdgcn_mfma_f32_16x16x32_bf16(wf[4096 + sg_ * 64], X[s], acc, 0, 0, 0); \
            const u32x4 xw = *reinterpret_cast<const u32x4*>(&X[s]); \
            _Pragma("unroll") for (int i = 0; i < 4; ++i) { const float a = __uint_as_float(xw[i] << 16), c_ = __uint_as_float(xw[i] & 0xffff0000u); ss = fmaf(a, a, ss); ss = fmaf(c_, c_, ss); } }
#pragma unroll
        for (int s = 0; s < 8; ++s) xb[s] = xp[(8 + s) * 4];
        P4_CHUNK(xa, 0)
#pragma unroll
        for (int s = 0; s < 8; ++s) xa[s] = xp[(16 + s) * 4];
        P4_CHUNK(xb, 1)
#pragma unroll
        for (int s = 0; s < 8; ++s) xb[s] = xp[(24 + s) * 4];
        P4_CHUNK(xa, 2)
        P4_CHUNK(xb, 3)
#undef P4_CHUNK
        ss += __shfl_xor(ss, 16); ss += __shfl_xor(ss, 32);
        const float r = 1.0f / sqrtf(ss * (1.f / D) + EPS);
        float lg[4], mx;
#pragma unroll
        for (int i = 0; i < 4; ++i) lg[i] = acc[i] * r;
        mx = fmaxf(fmaxf(lg[0], lg[1]), fmaxf(lg[2], lg[3])); mx = fmaxf(mx, __shfl_xor(mx, 16)); mx = fmaxf(mx, __shfl_xor(mx, 32));
        float ex[4], se = 0.f;
#pragma unroll
        for (int i = 0; i < 4; ++i) { ex[i] = expf(lg[i] - mx); se += ex[i]; }
        se += __shfl_xor(se, 16); se += __shfl_xor(se, 32);
        const int b = row / L, t = row - b * L;
#pragma unroll
        for (int i = 0; i < 4; ++i) F.AFF()[((size_t)b * NE + 4 * fq + i) * L + t] = ex[i] / se;
        u32x4* op = (u32x4*)(F.N2() + (size_t)row * D + 8 * fq);
#pragma unroll 1
        for (int c = 0; c < 4; ++c) {
            bf16x8 xc[8];
#pragma unroll
            for (int s = 0; s < 8; ++s) xc[s] = xp[(c * 8 + s) * 4];
#pragma unroll
            for (int s = 0; s < 8; ++s) { const int sg_ = c * 8 + s; const u32x4 xw = *reinterpret_cast<const u32x4*>(&xc[s]);
                const f32x4 g0 = *(const LAS f32x4*)(gl + 32 * sg_ + 8 * fq), g1 = *(const LAS f32x4*)(gl + 32 * sg_ + 8 * fq + 4);
                u32x4 w;
                w.x = cvtpk(__uint_as_float(xw.x << 16) * r * g0[0], __uint_as_float(xw.x & 0xffff0000u) * r * g0[1]);
                w.y = cvtpk(__uint_as_float(xw.y << 16) * r * g0[2], __uint_as_float(xw.y & 0xffff0000u) * r * g0[3]);
                w.z = cvtpk(__uint_as_float(xw.z << 16) * r * g1[0], __uint_as_float(xw.z & 0xffff0000u) * r * g1[1]);
                w.w = cvtpk(__uint_as_float(xw.w << 16) * r * g1[2], __uint_as_float(xw.w & 0xffff0000u) * r * g1[3]);
                op[sg_ * 4] = w; }
        }
    }
    __syncthreads();
}

__device__ __forceinline__ void p5_topk(Frame& F) {
    LAS unsigned* vals = (LAS unsigned*)F.lds;
    LAS unsigned* hist = vals + 4224;
    LAS unsigned* sh = hist + 256;
    const int tid = F.tid, lane = F.lane, wave = F.wave;
    for (int pb = F.vcu; pb < NB * NE; pb += F.G) {
        const int b = pb >> 4, e = pb & 15;
        const float* aff = F.AFF() + (size_t)pb * L;
        for (int i = tid; i < L; i += 512) vals[i] = __float_as_uint(aff[i]);
        if (tid == 0) { sh[0] = 0u; sh[1] = (unsigned)CAP; }
        __syncthreads();
        unsigned prefix = 0u, mask = 0u;
        for (int pass = 3; pass >= 0; --pass) {
            const int shift = pass * 8;
            if (tid < 256) hist[tid] = 0u;
            __syncthreads();
            for (int i = tid; i < L; i += 512) { const unsigned v = vals[i]; if ((v & mask) == prefix) atomicAdd((unsigned*)&hist[(v >> shift) & 255u], 1u); }
            __syncthreads();
            if (wave == 0) {
                const unsigned kk = sh[1];
                const unsigned h0 = hist[4 * lane], h1 = hist[4 * lane + 1], h2 = hist[4 * lane + 2], h3 = hist[4 * lane + 3];
                const unsigned tot = h0 + h1 + h2 + h3;
                unsigned incl = tot;
#pragma unroll
                for (int off = 1; off < 64; off <<= 1) { const unsigned o = __shfl_down(incl, off); if (lane + off < 64) incl += o; }
                const unsigned above = incl - tot;
                if (above < kk && kk <= incl) {
                    unsigned c = above; int bin; unsigned before;
                    if (c + h3 >= kk) { bin = 3; before = c; } else { c += h3; if (c + h2 >= kk) { bin = 2; before = c; } else { c += h2; if (c + h1 >= kk) { bin = 1; before = c; } else { c += h1; bin = 0; before = c; } } }
                    sh[0] = prefix | ((unsigned)(4 * lane + bin) << shift); sh[1] = kk - before;
                }
            }
            __syncthreads();
            prefix = sh[0]; mask |= 255u << shift;
            __syncthreads();
        }
        const unsigned T = prefix, need = sh[1];
        const int i0 = tid * 9; unsigned cg = 0, ce = 0;
#pragma unroll
        for (int k = 0; k < 9; ++k) { const int i = i0 + k; if (i < L) { const unsigned v = vals[i]; cg += (v > T); ce += (v == T); } }
        unsigned sg = cg, se = ce;
#pragma unroll
        for (int off = 1; off < 64; off <<= 1) { const unsigned a = __shfl_up(sg, off), c2 = __shfl_up(se, off); if (lane >= off) { sg += a; se += c2; } }
        if (lane == 63) { sh[8 + wave] = sg; sh[16 + wave] = se; }
        __syncthreads();
        unsigned bg = 0, be = 0;
        for (int w = 0; w < wave; ++w) { bg += sh[8 + w]; be += sh[16 + w]; }
        unsigned pg = bg + sg - cg, pe = be + se - ce;
#pragma unroll
        for (int k = 0; k < 9; ++k) { const int i = i0 + k; if (i < L) { const unsigned v = vals[i];
            const bool isg = v > T, ise = v == T;
            if (isg || (ise && pe < need)) { const unsigned slot = pg + (pe < need ? pe : need); const int r = b * CAP + (int)slot;
                F.ROWIDX()[e * CEP + r] = b * L + i; F.GATE()[e * CEP + r] = __uint_as_float(v); F.INV()[((size_t)b * L + i) * 16 + e] = r; }
            pg += isg; pe += ise; } }
        if (b == 0) for (int r = CE + tid; r < CEP; r += 512) { F.ROWIDX()[e * CEP + r] = 0; F.GATE()[e * CEP + r] = 0.f; }
        __syncthreads();
    }
}

__device__ __forceinline__ void p6_gather(Frame& F) {
    const int gw = F.vcu * NWAVES + F.wave, NGW = F.G * NWAVES, lane = F.lane;
    for (int r = gw; r < NE * CEP; r += NGW) {
        const int src = F.ROWIDX()[r];
        const u32x4* s = (const u32x4*)(F.N2() + (size_t)src * D); u32x4* d = (u32x4*)(F.XG() + (size_t)r * D);
        d[lane] = s[lane]; d[lane + 64] = s[lane + 64];
    }
}

__device__ __forceinline__ void p9_final(Frame& F) {
    const int gw = F.vcu * NWAVES + F.wave, NGW = F.G * NWAVES, lane = F.lane;
    f32x4 gf[4];
#pragma unroll
    for (int j = 0; j < 4; ++j) gf[j] = ((const f32x4*)F.g_final)[lane + 64 * j];
    for (int om = gw; om < NB * SEQ; om += NGW) {
        const int b = om >> 12, t = (om & 4095) + NMETA, m = b * L + t;
        f32x4 v[4];
        LDH1(v, m);
        const int myinv = F.INV()[(size_t)m * 16 + (lane & 15)];
        for (int e = 0; e < NE; ++e) { const int r = __shfl(myinv, e); if (r >= 0) {
            const unsigned long long* yr = (const unsigned long long*)(F.Y() + ((size_t)e * CEP + r) * D) + lane;
#pragma unroll
            for (int j = 0; j < 4; ++j) { const unsigned long long w = yr[64 * j]; const unsigned lo = (unsigned)w, hi = (unsigned)(w >> 32);
                v[j].x += __uint_as_float(lo << 16); v[j].y += __uint_as_float(lo & 0xffff0000u); v[j].z += __uint_as_float(hi << 16); v[j].w += __uint_as_float(hi & 0xffff0000u); } } }
        float s = 0.f;
#pragma unroll
        for (int j = 0; j < 4; ++j) s += (v[j].x * v[j].x + v[j].y * v[j].y) + (v[j].z * v[j].z + v[j].w * v[j].w);
        const float r = 1.0f / sqrtf(wave_sum(s) * (1.f / D) + EPS);
        f32x4* orow = (f32x4*)(F.out + (size_t)om * D) + lane;
#pragma unroll
        for (int j = 0; j < 4; ++j) orow[64 * j] = v[j] * r * gf[j];
    }
}

constexpr int MFULL = 16384;
__device__ __forceinline__ void p1_tail(Frame& F) {
    const int gw = F.vcu * NWAVES + F.wave, NGW = F.G * NWAVES, lane = F.lane, tok = lane & 15, q = lane >> 4;
    for (int t = gw; t < 4 * 128; t += NGW) { const int mt = t & 3, nt = t >> 2, m0 = MFULL + mt * 16, n0 = nt * 16;
        f32x4 a0, a1; skinny_mma<false>(F.XN0() + (size_t)m0 * D, D, F.WIN(), D / 8, n0, 0, 0, D, lane, a0, a1);
        const float sc = n0 < 512 ? C2 : 1.f;
        u32x2 w; w.x = cvtpk(a0[0] * sc, a0[1] * sc); w.y = cvtpk(a0[2] * sc, a0[3] * sc);
        *(u32x2*)(F.QKVU() + (size_t)(m0 + tok) * INW + n0 + 4 * q) = w; }
}
__device__ __forceinline__ void p3_tail(Frame& F) {
    const int gw = F.vcu * NWAVES + F.wave, NGW = F.G * NWAVES, lane = F.lane, tok = lane & 15, q = lane >> 4;
    for (int t = gw; t < 4 * 64; t += NGW) { const int mt = t & 3, nt = t >> 2, m0 = MFULL + mt * 16, n0 = nt * 16;
        f32x4 a0, a1; skinny_mma<false>(F.MIX() + (size_t)m0 * D, D, F.WO(), D / 8, n0, 0, 0, D, lane, a0, a1);
        const int m = m0 + tok; const f32x4 bs = *(const f32x4*)(h0_row(F.x, F.meta, m) + n0 + 4 * q);
        const f32x4 hv = bs + a0; u32x2 w; w.x = cvtpk(hv[0], hv[1]); w.y = cvtpk(hv[2], hv[3]);
        *(u32x2*)(F.H1() + (size_t)m * D + n0 + 4 * q) = w; }
}
__global__ void __launch_bounds__(NWAVES * 64, 2) mk_fwd(Args args) {
    extern __shared__ __attribute__((aligned(16))) unsigned char lds[];
    Frame F;
    F.lds = (LAS unsigned char*)lds;
    F.MISC = (volatile LAS unsigned*)(F.lds + MISC_OFF);
    F.tid = threadIdx.x; F.lane = F.tid & 63; F.wave = __builtin_amdgcn_readfirstlane(F.tid >> 6);
    F.G = gridDim.x; { const int bx = blockIdx.x; F.vcu = (F.G % 8 == 0) ? (bx % 8) * (F.G / 8) + bx / 8 : bx; }
    unsigned char* ws = args.ws;
    F.ctl = (unsigned*)(ws + WS_CTL);
    F.x = args.in[0]; F.meta = args.in[1]; F.g_mix = args.in[2]; F.w_in = args.in[3]; F.lam_vecs = args.in[4]; F.subln = args.in[5]; F.pool_w = args.in[6];
    F.pool_scale = args.in[7]; F.w_o = args.in[8]; F.g_ffn = args.in[9]; F.router_w = args.in[10]; F.w_gate = args.in[11]; F.w_up = args.in[12]; F.w_down = args.in[13]; F.g_final = args.in[14];
    F.out = args.out;
    F.ws = ws;
    for (int u = F.tid; u < (LDS_BYTES - LDSCTL_OFF) / 4; u += NWAVES * 64) ((LAS unsigned*)(F.lds + LDSCTL_OFF))[u] = 0u;
    __syncthreads();
    const int lo = args.ph_lo, hi = args.ph_hi;
    XcdBarrier bar; bar.bar = F.ctl + CW_BAR; bar.x = 0; bar.st = nullptr;
    if (!FLAT_BARRIER && hi - lo > 1) bar = xcd_barrier_post(F.ctl + CW_BAR, F.MISC + 8);
#ifndef PHASE_MASK
#define PHASE_MASK 0x7ff
#endif
#define IN(k) (((PHASE_MASK >> (k)) & 1) && lo <= (k) && (k) < hi)
    unsigned bar_epoch = 0;
#define SEAM(k) do { if (IN(k) && IN((k) + 1)) { if (FLAT_BARRIER) flat_barrier(F.ctl + CW_BAR, bar_epoch); else xcd_barrier(bar); } } while (0)
    if (IN(0)) { p0_prologue(F); } SEAM(0);
    if (IN(1)) { p1_tail(F); pg8::Gemm g{F.XN0(), F.WIN(), MFULL, INW, D, nullptr}; pg8::StaticOrder S; S.init(MFULL, INW, F.G, (int)blockIdx.x, MFULL); EpiProj E{F.QKVU()};
                 pg8::gemm_phase<EpiProj, pg8::StaticOrder, true, true>(F.lds, g, S, E); } SEAM(1);
    if (IN(2)) { p2_pool(F); const int ct = p2_attention<0>(F, F.vcu * NWAVES + F.wave); p0b_expert_weights(F, ct); } SEAM(2);
#if PROBE_ABL
    if (IN(9)) { (void)p2_attention<(PROBE_ABL & 15)>(F, (PROBE_ABL & 16) ? F.vcu * NWAVES + F.wave : (1 << 30)); }
#endif
    if (IN(3)) { p3_tail(F); pg8::Gemm g{F.MIX(), F.WO(), MFULL, D, D, nullptr}; pg8::StaticOrder S; S.init(MFULL, D, F.G, (int)blockIdx.x, MFULL); EpiRes E{F.x, F.meta, F.H1()};
                 pg8::gemm_phase<EpiRes, pg8::StaticOrder, true, true>(F.lds, g, S, E); } SEAM(3);
    if (IN(4)) { p4_norm_router(F); } SEAM(4);
    if (IN(5)) { p5_topk(F); } SEAM(5);
    if (IN(6)) { pg8::Gemm g{F.N2(), F.BT1(), NE * CEP, NE * 5632, D, F.ROWIDX()}; Moe1Order S{F.vcu, (args.flags & 1) ? 0 : 256}; EpiSwiGLU E{F.HID()};
                 pg8::gemm_phase<EpiSwiGLU, Moe1Order, true, false, true, true, true>(F.lds, g, S, E); } SEAM(6);
    if (IN(7)) { pg8::Gemm g{F.HID(), F.BT2(), NE * CEP, NE * D, FF, nullptr}; Moe2Order S{F.vcu, (args.flags & 1) ? 0 : 256}; EpiY E{F.Y(), F.GATE()};
                 pg8::gemm_phase<EpiY, Moe2Order, true, false, false, true, true>(F.lds, g, S, E); } SEAM(7);
    if (IN(8)) { p9_final(F); }
#if PROBE_PF
    if (IN(10)) { pg8::Gemm g{F.N2(), F.BT1(), NE * CEP, NE * 5632, D, F.ROWIDX()}; Moe1Order S{F.vcu, 256}; EpiSwiGLU E{F.HID()};
                  pg8::gemm_phase<EpiSwiGLU, Moe1Order, true, false, true, true, true, PROBE_PF>(F.lds, g, S, E); }
#endif
#undef IN
#undef SEAM
}

extern "C" void kernel_launch(void* const* d_in, const int* in_sizes, int n_in, void* d_out, int out_size, void* d_ws, size_t ws_size, hipStream_t stream) {
    static int grid = 0;
    if (grid == 0) {
        if (n_in != 15 || in_sizes[0] != NB * SEQ * D || out_size != NB * SEQ * D || ws_size < WS_END) {
            fprintf(stderr, "kernel_launch: shape mismatch: n_in %d in0 %d out %d ws %zu (need %zu)\n", n_in, n_in > 0 ? in_sizes[0] : -1, out_size, ws_size, (size_t)WS_END); grid = -1; return; }
        if (hipFuncSetAttribute((const void*)mk_fwd, hipFuncAttributeMaxDynamicSharedMemorySize, LDS_BYTES) != hipSuccess) { fprintf(stderr, "kernel_launch: hipFuncSetAttribute failed\n"); grid = -1; return; }
        int dev = 0, cus = 0;
        if (hipGetDevice(&dev) != hipSuccess || hipDeviceGetAttribute(&cus, hipDeviceAttributeMultiprocessorCount, dev) != hipSuccess) { grid = -1; return; }
        if (cus < 256) { fprintf(stderr, "kernel_launch: needs 256 CUs, device has %d\n", cus); grid = -1; return; }
        (void)hipGetLastError();
        grid = 256;
    }
    if (grid < 0) return;
    if (hipMemsetAsync((char*)d_ws + WS_CTL, 0, CTL_ZERO_BYTES, stream) != hipSuccess) { fprintf(stderr, "kernel_launch: memset failed\n"); return; }
    Args a{};
    for (int i = 0; i < 15; ++i) a.in[i] = (const float*)d_in[i];
    a.out = (float*)d_out; a.ws = (unsigned char*)d_ws;
#if ONE_LAUNCH
    a.ph_lo = 0; a.ph_hi = NPHASE;
    hipLaunchKernelGGL(mk_fwd, dim3(grid), dim3(NWAVES * 64), LDS_BYTES, stream, a);
#if PROBE_PHASE >= 0
    a.ph_lo = PROBE_PHASE; a.ph_hi = PROBE_PHASE + 1; a.flags = PROBE_NOMMA;
    hipLaunchKernelGGL(mk_fwd, dim3(grid), dim3(NWAVES * 64), LDS_BYTES, stream, a);
#endif
#else
    for (int p = 0; p < NPHASE; ++p) { a.ph_lo = p; a.ph_hi = p + 1; hipLaunchKernelGGL(mk_fwd, dim3(grid), dim3(NWAVES * 64), LDS_BYTES, stream, a); }
#endif
    const hipError_t le = hipPeekAtLastError();
    if (le != hipSuccess) fprintf(stderr, "kernel_launch: launch failed: %s\n", hipGetErrorName(le));
}
```
